# Optimizing an MI355X kernel written in HIP

```python
import jax, jax.numpy as jnp
from jax import lax
import numpy as np

D_MODEL = 1024
BATCH = 4
SEQ = 8192
DEPTH = 1

CONV_WIDTH = D_MODEL
CONV_K = 3
HEAD_DIM = 64
N_Q_HEADS = 8
N_KV_HEADS = 2
GQA_GROUP = N_Q_HEADS // N_KV_HEADS
WINDOW = 128
BLOCK = WINDOW
ROPE_THETA = 10000.0
Q_WIDTH = N_Q_HEADS * HEAD_DIM
KV_WIDTH = N_KV_HEADS * HEAD_DIM
D_FF = 2816
FFN_CONV_K = 3
EPS = 1e-5

IN_SIZES = (CONV_WIDTH, CONV_WIDTH, CONV_WIDTH, Q_WIDTH, KV_WIDTH, KV_WIDTH, D_MODEL, D_MODEL)
IN_WIDTH = sum(IN_SIZES)
IN_SPLITS = tuple(int(c) for c in np.cumsum(IN_SIZES)[:-1])

kernel_name = "hybrid_shortconv_swa_sinks_convffn"


def rmsnorm(x, w):
    xf = x.astype(jnp.float32)
    xf = xf * lax.rsqrt(jnp.mean(xf * xf, axis=-1, keepdims=True) + EPS)
    return xf.astype(x.dtype) * w


def causal_dwconv(v, w, b=None):
    k_taps = w.shape[0]
    s = v.shape[1]
    vp = jnp.pad(v, ((0, 0), (k_taps - 1, 0), (0, 0)))
    y = sum(w[i] * vp[:, i:i + s] for i in range(k_taps))
    if b is not None:
        y = y + b
    return y


def rope_tables(positions, dtype):
    inv_freq = ROPE_THETA ** (-jnp.arange(0, HEAD_DIM, 2, dtype=jnp.float32) / HEAD_DIM)
    ang = positions.astype(jnp.float32)[..., None] * inv_freq
    return jnp.cos(ang)[:, :, None, :].astype(dtype), jnp.sin(ang)[:, :, None, :].astype(dtype)


def apply_rope(x, cos, sin):
    x1, x2 = jnp.split(x, 2, axis=-1)
    return jnp.concatenate([x1 * cos - x2 * sin, x2 * cos + x1 * sin], axis=-1)


def sliding_window_attention(q, k, v, sinks):
    b, s = q.shape[:2]
    nb = s // BLOCK
    qb = q.reshape(b, nb, BLOCK, N_KV_HEADS, GQA_GROUP, HEAD_DIM)

    def with_prev(t):
        tb = t.reshape(b, nb, BLOCK, N_KV_HEADS, HEAD_DIM)
        prev = jnp.pad(tb[:, :-1], ((0, 0), (1, 0), (0, 0), (0, 0), (0, 0)))
        return jnp.concatenate([prev, tb], axis=2)

    kk, vv = with_prev(k), with_prev(v)
    scale = HEAD_DIM ** -0.5
    scores = jnp.einsum('bnqhgd,bnkhd->bnhgqk', qb, kk).astype(jnp.float32) * scale

    q_pos = jnp.arange(BLOCK)[:, None] + BLOCK
    k_pos = jnp.arange(2 * BLOCK)[None, :]
    rel = q_pos - k_pos
    band = (rel >= 0) & (rel < WINDOW)
    not_pad = (jnp.arange(nb)[:, None, None] > 0) | (k_pos[None] >= BLOCK)
    valid = band[None] & not_pad
    scores = jnp.where(valid[None, :, None, None], scores, -jnp.inf)

    sink = sinks.astype(jnp.float32).reshape(N_KV_HEADS, GQA_GROUP)[None, None, :, :, None, None]
    m = jnp.maximum(jnp.max(scores, axis=-1, keepdims=True), sink)
    p = jnp.exp(scores - m)
    denom = jnp.sum(p, axis=-1, keepdims=True) + jnp.exp(sink - m)
    probs = (p / denom).astype(v.dtype)
    out = jnp.einsum('bnhgqk,bnkhd->bnqhgd', probs, vv)
    return out.reshape(b, s, Q_WIDTH)


def setup_inputs(seed: int = 0) -> dict:
    key = jax.random.key(seed)
    ks = jax.random.split(key, 20)
    f32 = jnp.float32

    def nrm(k, shape, scale):
        return jax.random.normal(k, shape, f32) * scale

    x = jax.random.normal(ks[0], (BATCH, SEQ, D_MODEL), f32)
    positions = jnp.broadcast_to(jnp.arange(SEQ, dtype=jnp.int32), (BATCH, SEQ))
    return {
        "x": x,
        "positions": positions,
        "norm_mix_w": 1.0 + nrm(ks[1], (DEPTH, D_MODEL), 0.02),
        "w_in": nrm(ks[2], (DEPTH, D_MODEL, IN_WIDTH), D_MODEL ** -0.5),
        "b_in": nrm(ks[3], (DEPTH, IN_WIDTH), 0.02),
        "conv_mix_w": nrm(ks[4], (DEPTH, CONV_K, CONV_WIDTH), CONV_K ** -0.5),
        "w_conv_out": nrm(ks[5], (DEPTH, CONV_WIDTH, D_MODEL), CONV_WIDTH ** -0.5),
        "w_attn_out": nrm(ks[6], (DEPTH, Q_WIDTH, D_MODEL), Q_WIDTH ** -0.5),
        "b_attn_out": nrm(ks[7], (DEPTH, D_MODEL), 0.02),
        "sinks": nrm(ks[8], (DEPTH, N_Q_HEADS), 1.0),
        "w_mix_out": nrm(ks[9], (DEPTH, D_MODEL, D_MODEL), D_MODEL ** -0.5),
        "norm_ffn_w": 1.0 + nrm(ks[10], (DEPTH, D_MODEL), 0.02),
        "w_ffn_up": nrm(ks[11], (DEPTH, D_MODEL, 2 * D_FF), D_MODEL ** -0.5),
        "ffn_conv_w": nrm(ks[12], (DEPTH, FFN_CONV_K, D_FF), FFN_CONV_K ** -0.5),
        "ffn_conv_b": nrm(ks[13], (DEPTH, D_FF), 0.02),
        "w_ffn_down": nrm(ks[14], (DEPTH, D_FF, D_MODEL), D_FF ** -0.5),
        "norm_final_w": 1.0 + nrm(ks[15], (D_MODEL,), 0.02),
    }


def reference(x, positions, norm_mix_w, w_in, b_in, conv_mix_w, w_conv_out, w_attn_out,
              b_attn_out, sinks, w_mix_out, norm_ffn_w, w_ffn_up, ffn_conv_w, ffn_conv_b,
              w_ffn_down, norm_final_w):
    b, s, _ = x.shape
    cos, sin = rope_tables(positions, x.dtype)
    for l in range(DEPTH):
        u = rmsnorm(x, norm_mix_w[l])
        proj = u @ w_in[l] + b_in[l]
        cb, cc, cx, q, k, v, g_conv, g_attn = jnp.split(proj, IN_SPLITS, axis=-1)

        y_conv = (cb * causal_dwconv(cc * cx, conv_mix_w[l])) @ w_conv_out[l]

        q = apply_rope(q.reshape(b, s, N_Q_HEADS, HEAD_DIM), cos, sin)
        k = apply_rope(k.reshape(b, s, N_KV_HEADS, HEAD_DIM), cos, sin)
        v = v.reshape(b, s, N_KV_HEADS, HEAD_DIM)
        y_attn = sliding_window_attention(q, k, v, sinks[l]) @ w_attn_out[l] + b_attn_out[l]

        merged = jax.nn.sigmoid(g_conv) * y_conv + jax.nn.sigmoid(g_attn) * y_attn
        x = x + merged @ w_mix_out[l]

        u = rmsnorm(x, norm_ffn_w[l])
        up, gate = jnp.split(u @ w_ffn_up[l], 2, axis=-1)
        a = causal_dwconv(up, ffn_conv_w[l], ffn_conv_b[l])
        x = x + (jax.nn.silu(a) * gate) @ w_ffn_down[l]
    return rmsnorm(x, norm_final_w)
```

```cpp
#include <hip/hip_runtime.h>
#include <hip/hip_cooperative_groups.h>
#include <cstdio>
#include <cstdint>
#include <cstddef>
namespace cg = cooperative_groups;
namespace pg8 {
#define PG8_LAS __attribute__((address_space(3)))
typedef unsigned short bf16_t;
typedef short bf16x8 __attribute__((ext_vector_type(8)));
typedef float f32x4 __attribute__((ext_vector_type(4)));
typedef unsigned u32x4 __attribute__((ext_vector_type(4)));
constexpr int BM = 256, BK = 64, HALF = 128, HTB = HALF * BK * 2  , STAGE_BYTES = 8 * HTB, NXCD = 8, WGM = 8;

__host__ __device__ __forceinline__ int lds_byte(int r, int c) { const int st = (r >> 4) * 2 + (c >> 5), rr = r & 15, cc = c & 31, ob = rr * 64 + cc * 2; return st * 1024 + (ob ^ (((ob >> 9) & 1) << 5)); }
__host__ __device__ __forceinline__ void stage_rc(int b, int& R, int& C) { const int st = b / 1024, sb = b % 1024, swz = sb ^ (((sb >> 9) & 1) << 5); R = (st >> 1) * 16 + swz / 64; C = (st & 1) * 32 + (swz % 64) / 2; }
__host__ __device__ __forceinline__ int perm32(int rho) { const int n = rho >> 4, i = rho & 15; return 8 * (i >> 2) + 4 * n + (i & 3); }

struct Unit { int pm, pn; };
struct Gemm { const bf16_t* A; const bf16_t* Bt; int M, N, K; };

struct StaticOrder {
    int nM, nN, nwg, G, c;
    __host__ __device__ void init(int M, int N, int G_, int c_) { nM = M / BM; nN = N / BM; nwg = nM * nN; G = G_; c = c_; }
    __host__ __device__ bool next(int i, Unit& u) const {
        const long L = (long)i * G + c; if (L >= nwg) return false;
        int wgid = (int)L; { const int q = nwg / NXCD, r = nwg % NXCD, xcd = wgid % NXCD, off = wgid / NXCD; wgid = (xcd < r ? xcd * (q + 1) : r * (q + 1) + (xcd - r) * q) + off; }
        const int nig = WGM * nN, gid = wgid / nig, fm = gid * WGM, gsz = (nM - fm) < WGM ? (nM - fm) : WGM;
        u.pm = fm + ((wgid % nig) % gsz); u.pn = (wgid % nig) / gsz; return true;
    }
    __device__ __forceinline__ void a_ready(const Unit&) const {}
    __device__ __forceinline__ void done(const Unit&) const {}
};

__device__ __forceinline__ unsigned cvt_pk_bf16(float lo, float hi) { unsigned r; asm volatile("v_cvt_pk_bf16_f32 %0, %1, %2" : "=v"(r) : "v"(lo), "v"(hi)); return r; }
template <class Epi, class Sched, bool ALIGN_EPI = false, bool SP2 = false>
__device__ __forceinline__ void gemm_phase(PG8_LAS unsigned char* lds, const Gemm g, const Sched& S, const Epi& E) {
    const int tid = threadIdx.x, wid = __builtin_amdgcn_readfirstlane(tid >> 6), lane = tid & 63, wr = wid >> 2, wc = wid & 3, fr = lane & 15, fq = lane >> 4;
    const int K = g.K, nt = K / BK;
    unsigned voffA[2], voffB[2];
#pragma unroll
    for (int i = 0; i < 2; ++i) { int R, C; stage_rc(tid * 16 + i * 8192, R, C); const int Rb = Epi::PERM ? ((R & ~31) + perm32(R & 31)) : R;
        voffA[i] = (unsigned)(R * K + C) * 2u; voffB[i] = (unsigned)(Rb * K + C) * 2u; }
    const size_t kstep = (size_t)(BK * 2);
    const size_t hstep = (size_t)HALF * K * 2;
    const size_t tstep = 2 * hstep;
    const unsigned ldsw = (unsigned)wid * 1024u;
    const int aoff = lds_byte(wr * 64 + fr, fq * 8), boff = lds_byte(wc * 32 + fr, fq * 8);
#define PG8_SA(b, h) (((b) * 2 + (h)) * HTB)
#define PG8_SB(b, h) ((4 + (b) * 2 + (h)) * HTB)
#define PG8_STAGE(bufoff, gbase, voff) do { _Pragma("unroll") for (int _i = 0; _i < 2; ++_i) \
        __builtin_amdgcn_global_load_lds((const unsigned*)((const char*)(gbase) + (voff)[_i]), (PG8_LAS unsigned*)(lds + (bufoff) + ldsw + _i * 8192), 16, 0, 0); } while (0)
#define PG8_LDA(dst, b, h) do { _Pragma("unroll") for (int m = 0; m < 4; ++m) _Pragma("unroll") for (int k = 0; k < 2; ++k) dst[m][k] = *(const PG8_LAS bf16x8*)(lds + PG8_SA(b, h) + aoff + m * 2048 + k * 1024); } while (0)
#define PG8_LDB(dst, b, h) do { _Pragma("unroll") for (int n = 0; n < 2; ++n) _Pragma("unroll") for (int k = 0; k < 2; ++k) dst[n][k] = *(const PG8_LAS bf16x8*)(lds + PG8_SB(b, h) + boff + n * 2048 + k * 1024); } while (0)
#define PG8_MMA(ai, bj, At, Bt) do { __builtin_amdgcn_s_setprio(1); _Pragma("unroll") for (int m = 0; m < 4; ++m) _Pragma("unroll") for (int n = 0; n < 2; ++n) _Pragma("unroll") for (int k = 0; k < 2; ++k) \
        acc[ai][bj][m][n] = __builtin_amdgcn_mfma_f32_16x16x32_bf16(Bt[n][k], At[m][k], acc[ai][bj][m][n], 0, 0, 0); __builtin_amdgcn_s_setprio(0); } while (0)
#define PG8_WAIT_V(n) asm volatile("s_waitcnt vmcnt(" #n ")" ::: "memory")
#define PG8_WAIT_L(n) asm volatile("s_waitcnt lgkmcnt(" #n ")" ::: "memory")
#define PG8_BAR __builtin_amdgcn_s_barrier()
#define PG8_SCHED __builtin_amdgcn_sched_barrier(0)
    Unit cur, nxt; int ui = 0;
    if (!S.next(0, cur)) return;
    f32x4 acc[2][2][4][2];
#pragma unroll
    for (int a = 0; a < 2; ++a)
#pragma unroll
        for (int b = 0; b < 2; ++b)
#pragma unroll
            for (int m = 0; m < 4; ++m)
#pragma unroll
                for (int n = 0; n < 2; ++n) acc[a][b][m][n] = (f32x4){0.f, 0.f, 0.f, 0.f};
    bf16x8 At[4][2], B0[2][2], B1[2][2];
    const char* cA = (const char*)g.A + (size_t)cur.pm * tstep; const char* cB = (const char*)g.Bt + (size_t)cur.pn * tstep;
    S.a_ready(cur);
    if constexpr (SP2) {
        PG8_STAGE(PG8_SB(0, 0), cB, voffB); PG8_STAGE(PG8_SB(0, 1), cB + hstep, voffB); PG8_STAGE(PG8_SA(0, 0), cA, voffA); PG8_STAGE(PG8_SA(0, 1), cA + hstep, voffA);
        if (wr == 1) PG8_BAR;
        PG8_WAIT_V(2); PG8_BAR;
        PG8_STAGE(PG8_SB(1, 0), cB + kstep, voffB); PG8_STAGE(PG8_SA(1, 0), cA + kstep, voffA); PG8_STAGE(PG8_SB(1, 1), cB + hstep + kstep, voffB);
        PG8_WAIT_V(6); PG8_BAR;
    } else {
        PG8_STAGE(PG8_SB(0, 0), cB, voffB); PG8_STAGE(PG8_SA(0, 0), cA, voffA); PG8_STAGE(PG8_SB(0, 1), cB + hstep, voffB); PG8_STAGE(PG8_SA(0, 1), cA + hstep, voffA);
        if (wr == 1) PG8_BAR;
        PG8_WAIT_V(4); PG8_BAR;
        PG8_STAGE(PG8_SB(1, 0), cB + kstep, voffB); PG8_STAGE(PG8_SA(1, 0), cA + kstep, voffA); PG8_STAGE(PG8_SB(1, 1), cB + hstep + kstep, voffB);
        PG8_WAIT_V(6); PG8_BAR;
    }
    for (;;) {
        const bool has_next = S.next(ui + 1, nxt);
        const char* nA = has_next ? (const char*)g.A + (size_t)nxt.pm * tstep : cA; const char* nB = has_next ? (const char*)g.Bt + (size_t)nxt.pn * tstep : cB;
        for (int t = 0; t < nt; t += 2) {
            const bool last = (t == nt - 2);
            const char* a1 = cA + (size_t)(t + 1) * kstep;
            const char* a2 = last ? nA : cA + (size_t)(t + 2) * kstep; const char* b2 = last ? nB : cB + (size_t)(t + 2) * kstep;
            const char* a3 = a2 + kstep; const char* b3 = b2 + kstep;
            if (last && has_next) S.a_ready(nxt);
            if constexpr (SP2) {
            PG8_LDB(B0, 0, 0); PG8_LDB(B1, 0, 1); PG8_SCHED; PG8_LDA(At, 0, 0); PG8_STAGE(PG8_SA(1, 1), a1 + hstep, voffA);
            PG8_WAIT_V(8); PG8_WAIT_L(0); PG8_BAR; PG8_MMA(0, 0, At, B0); PG8_MMA(0, 1, At, B1); PG8_BAR; PG8_SCHED;
            PG8_LDA(At, 0, 1); PG8_STAGE(PG8_SB(0, 0), b2, voffB); PG8_STAGE(PG8_SB(0, 1), b2 + hstep, voffB); PG8_STAGE(PG8_SA(0, 0), a2, voffA);
            PG8_WAIT_V(8); PG8_WAIT_L(0); PG8_BAR; PG8_MMA(1, 0, At, B0); PG8_MMA(1, 1, At, B1); PG8_BAR; PG8_SCHED;
            PG8_LDB(B0, 1, 0); PG8_LDB(B1, 1, 1); PG8_SCHED; PG8_LDA(At, 1, 0); PG8_STAGE(PG8_SA(0, 1), a2 + hstep, voffA);
            PG8_WAIT_V(8); PG8_WAIT_L(0); PG8_BAR; PG8_MMA(0, 0, At, B0); PG8_MMA(0, 1, At, B1); PG8_BAR; PG8_SCHED;
            PG8_LDA(At, 1, 1); PG8_STAGE(PG8_SB(1, 0), b3, voffB); PG8_STAGE(PG8_SB(1, 1), b3 + hstep, voffB); PG8_STAGE(PG8_SA(1, 0), a3, voffA);
            PG8_WAIT_V(8); PG8_WAIT_L(0); PG8_BAR; PG8_MMA(1, 0, At, B0); PG8_MMA(1, 1, At, B1); PG8_BAR; PG8_SCHED;
            } else {
            PG8_LDB(B0, 0, 0); PG8_SCHED; PG8_LDA(At, 0, 0); PG8_STAGE(PG8_SA(1, 1), a1 + hstep, voffA);
            PG8_WAIT_L(8); PG8_BAR; PG8_WAIT_L(0); PG8_MMA(0, 0, At, B0); PG8_BAR; PG8_SCHED;
            PG8_LDB(B1, 0, 1); PG8_STAGE(PG8_SB(0, 0), b2, voffB);
            PG8_BAR; PG8_WAIT_L(0); PG8_MMA(0, 1, At, B1); PG8_BAR;
            PG8_LDA(At, 0, 1); PG8_STAGE(PG8_SA(0, 0), a2, voffA);
            PG8_BAR; PG8_WAIT_L(0); PG8_MMA(1, 0, At, B0); PG8_BAR; PG8_SCHED;
            PG8_STAGE(PG8_SB(0, 1), b2 + hstep, voffB);
            PG8_WAIT_V(6); PG8_BAR; PG8_MMA(1, 1, At, B1); PG8_BAR;
            PG8_LDB(B0, 1, 0); PG8_SCHED; PG8_LDA(At, 1, 0); PG8_STAGE(PG8_SA(0, 1), a2 + hstep, voffA);
            PG8_WAIT_L(8); PG8_BAR; PG8_WAIT_L(0); PG8_MMA(0, 0, At, B0); PG8_BAR; PG8_SCHED;
            PG8_LDB(B1, 1, 1); PG8_STAGE(PG8_SB(1, 0), b3, voffB);
            PG8_BAR; PG8_WAIT_L(0); PG8_MMA(0, 1, At, B1); PG8_BAR;
            PG8_LDA(At, 1, 1); PG8_STAGE(PG8_SA(1, 0), a3, voffA);
            PG8_BAR; PG8_WAIT_L(0); PG8_MMA(1, 0, At, B0); PG8_BAR; PG8_SCHED;
            PG8_STAGE(PG8_SB(1, 1), b3 + hstep, voffB);
            PG8_WAIT_V(6); PG8_BAR; PG8_MMA(1, 1, At, B1); PG8_BAR;
            }
        }
        if constexpr (ALIGN_EPI) { if (wr == 0) PG8_BAR; }
        if constexpr (!Epi::AFTER_DRAIN) { E(acc, cur, wr, wc, fr, fq); S.done(cur); }
        if (!has_next) break;
#pragma unroll
        for (int a = 0; a < 2; ++a)
#pragma unroll
            for (int b = 0; b < 2; ++b)
#pragma unroll
                for (int m = 0; m < 4; ++m)
#pragma unroll
                    for (int n = 0; n < 2; ++n) acc[a][b][m][n] = (f32x4){0.f, 0.f, 0.f, 0.f};
        cur = nxt; cA = nA; cB = nB; ++ui;
        if constexpr (ALIGN_EPI) { if (wr == 1) PG8_BAR; }
    }
    PG8_WAIT_V(0);
    if constexpr (!ALIGN_EPI) { if (wr == 0) PG8_BAR; }
    PG8_BAR;
    if constexpr (Epi::AFTER_DRAIN) { E.fused(acc, cur, wr, wc, fr, fq, lds, wid, lane); S.done(cur); }
#undef PG8_SA
#undef PG8_SB
#undef PG8_STAGE
#undef PG8_LDA
#undef PG8_LDB
#undef PG8_MMA
#undef PG8_WAIT_V
#undef PG8_WAIT_L
#undef PG8_BAR
#undef PG8_SCHED
}
}
#define DI __device__ __forceinline__
#define LAS __attribute__((address_space(3)))
typedef unsigned short bf16;
typedef float f32x4 __attribute__((ext_vector_type(4)));
typedef float f32x16 __attribute__((ext_vector_type(16)));
typedef unsigned u32x4 __attribute__((ext_vector_type(4)));
typedef unsigned u32x2 __attribute__((ext_vector_type(2)));
typedef short bf16x8 __attribute__((ext_vector_type(8)));
typedef short s16x4 __attribute__((ext_vector_type(4)));
typedef float f32x2_t __attribute__((ext_vector_type(2)));
typedef __bf16 bf16x2_t __attribute__((ext_vector_type(2)));

constexpr int NWAVES = 8;
constexpr int DM = 1024, BATCH = 4, SEQ = 8192, M = BATCH * SEQ;
constexpr int NIN = 5888, QW = 512, KVW = 128, DFF = 2816, NUP = 2 * DFF;
constexpr float EPS = 1e-5f;
constexpr float LOG2E = 1.4426950408889634f;
constexpr int LDS_BYTES = 147456;

constexpr size_t MiB = 1u << 20;
constexpr size_t WS_SS1 = 0, WS_SS2 = 128 * 1024, WS_BIAS1 = 256 * 1024;
constexpr size_t WS_RC = 1 * MiB, WS_RS = 5 * MiB;
constexpr size_t WS_WIN = 9 * MiB;
constexpr size_t WS_WCONV = WS_WIN + (size_t)NIN * DM * 2;
constexpr size_t WS_WATT = WS_WCONV + (size_t)DM * DM * 2;
constexpr size_t WS_WMIX = WS_WATT + (size_t)DM * QW * 2;
constexpr size_t WS_WUP = WS_WMIX + (size_t)DM * DM * 2;
constexpr size_t WS_WDOWN = WS_WUP + (size_t)NUP * DM * 2;
static_assert(WS_WDOWN + (size_t)DM * DFF * 2 <= 48 * MiB, "weights");
constexpr size_t WS_U = 48 * MiB;
constexpr size_t WS_CB = 112 * MiB;
constexpr size_t WS_P = 176 * MiB;
constexpr size_t WS_SGC = 240 * MiB, WS_SGA = 304 * MiB;
constexpr size_t WS_Q = 368 * MiB, WS_K = 400 * MiB, WS_VT = 408 * MiB, WS_ATT = 416 * MiB;
constexpr size_t WS_UPH = 368 * MiB, WS_GH = 392 * MiB;
constexpr size_t WS_END = 448 * MiB;
static_assert((size_t)512 * 4 * DFF * 4 <= 24 * MiB && (size_t)512 * 2 * DFF * 4 <= 16 * MiB, "halo");

DI unsigned pk(float lo, float hi) { f32x2_t v = {lo, hi}; bf16x2_t b = __builtin_convertvector(v, bf16x2_t); return __builtin_bit_cast(unsigned, b); }
DI u32x4 pk8(f32x4 a, f32x4 b) { u32x4 w; w.x = pk(a[0], a[1]); w.y = pk(a[2], a[3]); w.z = pk(b[0], b[1]); w.w = pk(b[2], b[3]); return w; }
DI f32x4 unlo(u32x4 w) { return (f32x4){__uint_as_float(w.x << 16), __uint_as_float(w.x & 0xffff0000u), __uint_as_float(w.y << 16), __uint_as_float(w.y & 0xffff0000u)}; }
DI f32x4 unhi(u32x4 w) { return (f32x4){__uint_as_float(w.z << 16), __uint_as_float(w.z & 0xffff0000u), __uint_as_float(w.w << 16), __uint_as_float(w.w & 0xffff0000u)}; }
DI float sigmoidf_(float x) { return __builtin_amdgcn_rcpf(1.0f + __builtin_amdgcn_exp2f(-x * LOG2E)); }
DI f32x4 sig4(f32x4 v) { return (f32x4){sigmoidf_(v[0]), sigmoidf_(v[1]), sigmoidf_(v[2]), sigmoidf_(v[3])}; }
DI float dpp_ror1(float s) { return __int_as_float(__builtin_amdgcn_update_dpp(0, __float_as_int(s), 0x121, 0xf, 0xf, false)); }
DI float dpp_ror2(float s) { return __int_as_float(__builtin_amdgcn_update_dpp(0, __float_as_int(s), 0x122, 0xf, 0xf, false)); }
DI float dpp_shr1(float old, float s) { return __int_as_float(__builtin_amdgcn_update_dpp(__float_as_int(old), __float_as_int(s), 0x111, 0xf, 0xf, false)); }
DI float dpp_shr2(float old, float s) { return __int_as_float(__builtin_amdgcn_update_dpp(__float_as_int(old), __float_as_int(s), 0x112, 0xf, 0xf, false)); }

__host__ __device__ inline int src_col_in(int n) {
    const int pn = n >> 8, c = n & 255, bj = c >> 7, cc = c & 127;
    if (pn < 4) return n;
    if (pn < 12) return (bj ? 2048 : 1024) + 128 * (pn - 4) + cc;
    if (pn < 14) return 3072 + (4 * (pn - 12) + (cc >> 5)) * 64 + (cc & 31) + 32 * bj;
    if (pn == 14) { const int w = cc >> 5, dd = cc & 31; return w < 2 ? 3584 + w * 64 + dd + 32 * bj : 3712 + bj * 64 + 32 * (w - 2) + dd; }
    if (pn < 19) return 3840 + (n - 15 * 256);
    return 4864 + (n - 19 * 256);
}
__host__ __device__ inline int src_col_up(int n) { const int pn = n >> 8, c = n & 255; return ((c >> 7) ? DFF : 0) + 128 * pn + (c & 127); }

using pg8::Unit;
struct Epi1 {
    static constexpr bool PERM = true, AFTER_DRAIN = false;
    const float* bias; bf16 *CB, *P, *Q, *K, *VT, *SGC, *SGA; const float *RC, *RS;
    DI void operator()(const f32x4 (&acc)[2][2][4][2], const Unit& u, int wr, int wc, int fr, int fq) const {
        const int pn = u.pn; const int row0 = u.pm * 256 + wr * 64 + fr; const int bcol0 = pn * 256 + wc * 32 + 8 * fq;
        f32x4 bv[2][2];
#pragma unroll
        for (int bj = 0; bj < 2; ++bj)
#pragma unroll
            for (int n = 0; n < 2; ++n) bv[bj][n] = *(const f32x4*)(bias + bcol0 + bj * 128 + 4 * n);
        if (pn < 4 || pn >= 15) {
            bf16* base; int colt; bool sig;
            if (pn < 4) { base = CB; colt = pn * 256; sig = false; } else if (pn < 19) { base = SGC; colt = (pn - 15) * 256; sig = true; } else { base = SGA; colt = (pn - 19) * 256; sig = true; }
            const int col0 = colt + wc * 32 + 8 * fq;
#pragma unroll
            for (int ai = 0; ai < 2; ++ai)
#pragma unroll
                for (int m = 0; m < 4; ++m) { bf16* rowp = base + (size_t)(row0 + ai * 128 + m * 16) * DM + col0;
#pragma unroll
                    for (int bj = 0; bj < 2; ++bj) { f32x4 v0 = acc[ai][bj][m][0] + bv[bj][0], v1 = acc[ai][bj][m][1] + bv[bj][1];
                        if (sig) { v0 = sig4(v0); v1 = sig4(v1); }
                        *(u32x4*)(rowp + bj * 128) = pk8(v0, v1); } }
        } else if (pn < 12) {
            const int col0 = (pn - 4) * 128 + wc * 32 + 8 * fq;
#pragma unroll
            for (int ai = 0; ai < 2; ++ai)
#pragma unroll
                for (int m = 0; m < 4; ++m) { bf16* rowp = P + (size_t)(row0 + ai * 128 + m * 16) * DM + col0;
                    const f32x4 p0 = (acc[ai][0][m][0] + bv[0][0]) * (acc[ai][1][m][0] + bv[1][0]), p1 = (acc[ai][0][m][1] + bv[0][1]) * (acc[ai][1][m][1] + bv[1][1]);
                    *(u32x4*)rowp = pk8(p0, p1); }
        } else if (pn < 14 || wc < 2) {
            bf16* base; int ld, hcol; float sc;
            if (pn < 14) { base = Q; ld = QW; hcol = ((pn - 12) * 4 + wc) * 64; sc = 0.125f; } else { base = K; ld = KVW; hcol = wc * 64; sc = 1.0f; }
#pragma unroll
            for (int ai = 0; ai < 2; ++ai)
#pragma unroll
                for (int m = 0; m < 4; ++m) { const int row = row0 + ai * 128 + m * 16;
                    const f32x4 c0 = *(const f32x4*)(RC + (size_t)row * 32 + 8 * fq), c1 = *(const f32x4*)(RC + (size_t)row * 32 + 8 * fq + 4);
                    const f32x4 s0 = *(const f32x4*)(RS + (size_t)row * 32 + 8 * fq), s1 = *(const f32x4*)(RS + (size_t)row * 32 + 8 * fq + 4);
                    const f32x4 a0 = acc[ai][0][m][0] + bv[0][0], a1 = acc[ai][0][m][1] + bv[0][1], b0 = acc[ai][1][m][0] + bv[1][0], b1 = acc[ai][1][m][1] + bv[1][1];
                    const f32x4 o10 = (a0 * c0 - b0 * s0) * sc, o11 = (a1 * c1 - b1 * s1) * sc, o20 = (b0 * c0 + a0 * s0) * sc, o21 = (b1 * c1 + a1 * s1) * sc;
                    bf16* rowp = base + (size_t)row * ld + hcol + 8 * fq;
                    *(u32x4*)rowp = pk8(o10, o11); *(u32x4*)(rowp + 32) = pk8(o20, o21); }
        } else {
#pragma unroll
            for (int ai = 0; ai < 2; ++ai)
#pragma unroll
                for (int m = 0; m < 4; ++m) { const int row = row0 + ai * 128 + m * 16; const int b = row >> 13, s = row & (SEQ - 1);
#pragma unroll
                    for (int bj = 0; bj < 2; ++bj)
#pragma unroll
                        for (int n = 0; n < 2; ++n) { const f32x4 v = acc[ai][bj][m][n] + bv[bj][n]; const unsigned w0 = pk(v[0], v[1]), w1 = pk(v[2], v[3]);
                            bf16* p = VT + ((size_t)((b * 2 + bj) * 64 + 32 * (wc - 2) + 8 * fq + 4 * n)) * SEQ + s;
                            p[0] = (bf16)(w0 & 0xffffu); p[SEQ] = (bf16)(w0 >> 16); p[2 * SEQ] = (bf16)(w1 & 0xffffu); p[3 * SEQ] = (bf16)(w1 >> 16); } }
        }
    }
};
struct Epi2a {
    static constexpr bool PERM = true, AFTER_DRAIN = false;
    const bf16* G; bf16* T;
    DI void operator()(const f32x4 (&acc)[2][2][4][2], const Unit& u, int wr, int wc, int fr, int fq) const {
        const int row0 = u.pm * 256 + wr * 64 + fr, col0 = u.pn * 256 + wc * 32 + 8 * fq;
#pragma unroll
        for (int ai = 0; ai < 2; ++ai)
#pragma unroll
            for (int m = 0; m < 4; ++m) { const size_t off = (size_t)(row0 + ai * 128 + m * 16) * DM + col0;
#pragma unroll
                for (int bj = 0; bj < 2; ++bj) { const u32x4 g = *(const u32x4*)(G + off + bj * 128);
                    *(u32x4*)(T + off + bj * 128) = pk8(acc[ai][bj][m][0] * unlo(g), acc[ai][bj][m][1] * unhi(g)); } }
    }
};
struct Epi2b {
    static constexpr bool PERM = true, AFTER_DRAIN = false;
    const bf16* G; const bf16* T; const float* bias; bf16* O;
    DI void operator()(const f32x4 (&acc)[2][2][4][2], const Unit& u, int wr, int wc, int fr, int fq) const {
        const int row0 = u.pm * 256 + wr * 64 + fr, col0 = u.pn * 256 + wc * 32 + 8 * fq;
        f32x4 bv[2][2];
#pragma unroll
        for (int bj = 0; bj < 2; ++bj)
#pragma unroll
            for (int n = 0; n < 2; ++n) bv[bj][n] = *(const f32x4*)(bias + col0 + bj * 128 + 4 * n);
#pragma unroll
        for (int ai = 0; ai < 2; ++ai)
#pragma unroll
            for (int m = 0; m < 4; ++m) { const size_t off = (size_t)(row0 + ai * 128 + m * 16) * DM + col0;
#pragma unroll
                for (int bj = 0; bj < 2; ++bj) { const u32x4 g = *(const u32x4*)(G + off + bj * 128); const u32x4 t = *(const u32x4*)(T + off + bj * 128);
                    *(u32x4*)(O + off + bj * 128) = pk8((acc[ai][bj][m][0] + bv[bj][0]) * unlo(g) + unlo(t), (acc[ai][bj][m][1] + bv[bj][1]) * unhi(g) + unhi(t)); } }
    }
};
template <bool WB> struct EpiRes {
    static constexpr bool PERM = false, AFTER_DRAIN = false;
    const float* base; float* out; bf16* XB; float* SS;
    DI void operator()(const f32x4 (&acc)[2][2][4][2], const Unit& u, int wr, int wc, int fr, int fq) const {
        const int row0 = u.pm * 256 + wr * 64 + fr, col0 = u.pn * 256 + wc * 32 + 4 * fq;
#pragma unroll
        for (int ai = 0; ai < 2; ++ai)
#pragma unroll
            for (int m = 0; m < 4; ++m) { const int row = row0 + ai * 128 + m * 16; const size_t off = (size_t)row * DM + col0; float ss = 0.f;
#pragma unroll
                for (int bj = 0; bj < 2; ++bj)
#pragma unroll
                    for (int n = 0; n < 2; ++n) { const size_t o2 = off + bj * 128 + n * 16; const f32x4 o = *(const f32x4*)(base + o2) + acc[ai][bj][m][n];
                        *(f32x4*)(out + o2) = o; ss += (o[0] * o[0] + o[1] * o[1]) + (o[2] * o[2] + o[3] * o[3]);
                        if (WB) { u32x2 w; w.x = pk(o[0], o[1]); w.y = pk(o[2], o[3]); *(u32x2*)(XB + o2) = w; } }
                ss += __shfl_xor(ss, 16); ss += __shfl_xor(ss, 32);
                if (fq == 0) atomicAdd(SS + row, ss); }
    }
};
struct Epi4 {
    static constexpr bool PERM = true, AFTER_DRAIN = false;
    const float* SS1; const float* cw; const float* cbias; bf16* H2; float* UPH; float* GH;
    DI void operator()(const f32x4 (&acc)[2][2][4][2], const Unit& u, int wr, int wc, int fr, int fq) const {
        const int ch0 = u.pn * 128 + wc * 32 + 8 * fq;
        f32x4 w0[2], w1[2], w2[2], bb[2];
#pragma unroll
        for (int n = 0; n < 2; ++n) { w0[n] = *(const f32x4*)(cw + ch0 + 4 * n); w1[n] = *(const f32x4*)(cw + DFF + ch0 + 4 * n); w2[n] = *(const f32x4*)(cw + 2 * DFF + ch0 + 4 * n); bb[n] = *(const f32x4*)(cbias + ch0 + 4 * n); }
#pragma unroll
        for (int ai = 0; ai < 2; ++ai) {
            const int chunk = u.pm * 4 + ai * 2 + wr;
            f32x4 prev[2] = {(f32x4){0.f, 0.f, 0.f, 0.f}, (f32x4){0.f, 0.f, 0.f, 0.f}};
#pragma unroll
            for (int m = 0; m < 4; ++m) {
                const int row = chunk * 64 + m * 16 + fr;
                const float rstd = __builtin_amdgcn_rsqf(SS1[row] * (1.0f / DM) + EPS);
                f32x4 hv[2];
#pragma unroll
                for (int n = 0; n < 2; ++n) {
                    const f32x4 up = acc[ai][0][m][n] * rstd, gate = acc[ai][1][m][n] * rstd;
                    f32x4 p1, p2;
#pragma unroll
                    for (int i = 0; i < 4; ++i) { p1[i] = dpp_shr1(dpp_ror1(prev[n][i]), up[i]); p2[i] = dpp_shr2(dpp_ror2(prev[n][i]), up[i]); }
                    const f32x4 a = w2[n] * up + w1[n] * p1 + w0[n] * p2 + bb[n];
                    hv[n] = a * sig4(a) * gate;
                    if (m == 3 && fr >= 14) *(f32x4*)(UPH + ((size_t)chunk * 4 + (fr - 14)) * DFF + ch0 + 4 * n) = up;
                    if (m == 0 && fr < 2) { *(f32x4*)(UPH + ((size_t)chunk * 4 + 2 + fr) * DFF + ch0 + 4 * n) = up; *(f32x4*)(GH + ((size_t)chunk * 2 + fr) * DFF + ch0 + 4 * n) = gate; }
                    prev[n] = up;
                }
                *(u32x4*)(H2 + (size_t)row * DFF + ch0) = pk8(hv[0], hv[1]);
            }
        }
    }
};

struct Params {
    const float* x; const int* pos; const float* norm_mix_w; const float* w_in; const float* b_in; const float* conv_mix_w; const float* w_conv_out;
    const float* w_attn_out; const float* b_attn_out; const float* sinks; const float* w_mix_out; const float* norm_ffn_w; const float* w_ffn_up;
    const float* ffn_conv_w; const float* ffn_conv_b; const float* w_ffn_down; const float* norm_final_w; float* out; unsigned char* ws;
};

DI float wave_sum(float v) {
#pragma unroll
    for (int o = 1; o < 64; o <<= 1) v += __shfl_xor(v, o);
    return v;
}
DI void transpose_item(const float* W, int K, int N, bf16* WT, int n0, int sc0, int k0, const float* kscale, LAS float* scr, int lane) {
#pragma unroll 8
    for (int i = 0; i < 32; ++i) { const int kk = 2 * i + (lane >> 5); float v = W[(size_t)(k0 + kk) * N + sc0 + (lane & 31)]; if (kscale) v *= kscale[k0 + kk]; scr[kk * 33 + (lane & 31)] = v; }
    asm volatile("s_waitcnt lgkmcnt(0)" ::: "memory");
    const int c = lane & 7;
#pragma unroll
    for (int j = 0; j < 4; ++j) { const int n = (lane >> 3) + 8 * j; const LAS float* s = scr + (8 * c) * 33 + n;
        u32x4 o; o.x = pk(s[0 * 33], s[1 * 33]); o.y = pk(s[2 * 33], s[3 * 33]); o.z = pk(s[4 * 33], s[5 * 33]); o.w = pk(s[6 * 33], s[7 * 33]);
        *(u32x4*)(WT + (size_t)(n0 + n) * K + k0 + 8 * c) = o; }
    asm volatile("s_waitcnt lgkmcnt(0)" ::: "memory");
}

DI void prologue(const Params& p, LAS unsigned char* lds, int wave, int lane) {
    unsigned char* ws = p.ws;
    LAS float* scr = (LAS float*)(lds + wave * 16384);
    const int gw = blockIdx.x * NWAVES + wave, NGW = gridDim.x * NWAVES;
    const int gt = gw * 64 + lane, NGT = NGW * 64;
    constexpr int I_IN = (DM / 64) * (NIN / 32), I_CONV = (DM / 64) * (DM / 32), I_ATT = (QW / 64) * (DM / 32), I_MIX = I_CONV, I_UP = (DM / 64) * (NUP / 32), I_DOWN = (DFF / 64) * (DM / 32);
    constexpr int NITEMS = I_IN + I_CONV + I_ATT + I_MIX + I_UP + I_DOWN;
    for (int it = gw; it < NITEMS; it += NGW) {
        int r = it;
        if (r < I_IN) { const int nb = r % (NIN / 32), kb = r / (NIN / 32); transpose_item(p.w_in, DM, NIN, (bf16*)(ws + WS_WIN), 32 * nb, src_col_in(32 * nb), 64 * kb, nullptr, scr, lane); continue; } r -= I_IN;
        if (r < I_CONV) { const int nb = r % (DM / 32), kb = r / (DM / 32); transpose_item(p.w_conv_out, DM, DM, (bf16*)(ws + WS_WCONV), 32 * nb, 32 * nb, 64 * kb, nullptr, scr, lane); continue; } r -= I_CONV;
        if (r < I_ATT) { const int nb = r % (DM / 32), kb = r / (DM / 32); transpose_item(p.w_attn_out, QW, DM, (bf16*)(ws + WS_WATT), 32 * nb, 32 * nb, 64 * kb, nullptr, scr, lane); continue; } r -= I_ATT;
        if (r < I_MIX) { const int nb = r % (DM / 32), kb = r / (DM / 32); transpose_item(p.w_mix_out, DM, DM, (bf16*)(ws + WS_WMIX), 32 * nb, 32 * nb, 64 * kb, nullptr, scr, lane); continue; } r -= I_MIX;
        if (r < I_UP) { const int nb = r % (NUP / 32), kb = r / (NUP / 32); transpose_item(p.w_ffn_up, DM, NUP, (bf16*)(ws + WS_WUP), 32 * nb, src_col_up(32 * nb), 64 * kb, p.norm_ffn_w, scr, lane); continue; } r -= I_UP;
        { const int nb = r % (DM / 32), kb = r / (DM / 32); transpose_item(p.w_ffn_down, DFF, DM, (bf16*)(ws + WS_WDOWN), 32 * nb, 32 * nb, 64 * kb, nullptr, scr, lane); }
    }
    { float* b1 = (float*)(ws + WS_BIAS1); for (int n = gt; n < NIN; n += NGT) b1[n] = p.b_in[src_col_in(n)];
      float* s1 = (float*)(ws + WS_SS1); float* s2 = (float*)(ws + WS_SS2); for (int n = gt; n < M; n += NGT) { s1[n] = 0.f; s2[n] = 0.f; } }
    { float* RC = (float*)(ws + WS_RC); float* RS = (float*)(ws + WS_RS);
      for (int e = gt; e < M * 32; e += NGT) { const int i = e & 31, row = e >> 5;
          const float inv = exp2f(-(float)i * (13.287712379549449f / 32.0f));
          const float ang = (float)p.pos[row] * inv;
          const double xd = (double)ang; const double kq = __builtin_rint(xd * 0.63661977236758134308);
          const double rr = __builtin_fma(-kq, 6.123233995736766e-17, __builtin_fma(-kq, 1.5707963267948966, xd));
          const double r2 = rr * rr;
          const double sn = rr * (1.0 + r2 * (-1.0 / 6 + r2 * (1.0 / 120 + r2 * (-1.0 / 5040 + r2 * (1.0 / 362880 + r2 * (-1.0 / 39916800 + r2 * (1.0 / 6227020800.0)))))));
          const double cs = 1.0 + r2 * (-0.5 + r2 * (1.0 / 24 + r2 * (-1.0 / 720 + r2 * (1.0 / 40320 + r2 * (-1.0 / 3628800 + r2 * (1.0 / 479001600.0))))));
          const int q = ((int)kq) & 3;
          const double c = (q == 0) ? cs : (q == 1) ? -sn : (q == 2) ? -cs : sn;
          const double s = (q == 0) ? sn : (q == 1) ? cs : (q == 2) ? -sn : -cs;
          RC[e] = (float)c; RS[e] = (float)s; } }
    { bf16* U = (bf16*)(ws + WS_U);
      f32x4 wv[4];
#pragma unroll
      for (int j = 0; j < 4; ++j) wv[j] = *((const f32x4*)p.norm_mix_w + lane + 64 * j);
      for (int m = gw; m < M; m += NGW) {
          const f32x4* xr = (const f32x4*)(p.x + (size_t)m * DM) + lane;
          f32x4 v[4]; float s = 0.f;
#pragma unroll
          for (int j = 0; j < 4; ++j) { v[j] = xr[64 * j]; s += (v[j].x * v[j].x + v[j].y * v[j].y) + (v[j].z * v[j].z + v[j].w * v[j].w); }
          const float rstd = __builtin_amdgcn_rsqf(wave_sum(s) * (1.0f / DM) + EPS);
          u32x2* o8 = (u32x2*)(U + (size_t)m * DM) + lane;
#pragma unroll
          for (int j = 0; j < 4; ++j) { const f32x4 o = v[j] * rstd * wv[j]; u32x2 w; w.x = pk(o[0], o[1]); w.y = pk(o[2], o[3]); o8[64 * j] = w; }
      } }
}

#define MFMA32(a, b, c) __builtin_amdgcn_mfma_f32_32x32x16_bf16((a), (b), (c), 0, 0, 0)
DI void attn_unit(const bf16* Q, const bf16* K, const bf16* VT, bf16* ATT, const float* sinks, int u, int lane) {
    const int hq = u & 7, n = (u >> 3) & 63, b = u >> 9, kvh = hq >> 2, r = lane & 31, h = lane >> 5;
    const ptrdiff_t tok0 = (ptrdiff_t)b * SEQ + n * 128;
    const float sink = sinks[hq];
    const bf16* Kb = K + (tok0 - 128 + r) * KVW + kvh * 64 + 8 * h;
    const bf16* Vb = VT + ((ptrdiff_t)((b * 2 + kvh) * 64 + r)) * SEQ + (n * 128 - 128) + 4 * h;
    f32x16 zero;
#pragma unroll
    for (int i = 0; i < 16; ++i) zero[i] = 0.f;
    for (int qi = 0; qi < 4; ++qi) {
        const bf16* qp = Q + (tok0 + 32 * qi + r) * QW + hq * 64 + 8 * h;
        bf16x8 bq[4];
#pragma unroll
        for (int st = 0; st < 4; ++st) bq[st] = *(const bf16x8*)(qp + 16 * st);
        f32x16 S[5];
#pragma unroll
        for (int kj = 0; kj < 5; ++kj) {
            const int kt = qi + kj; S[kj] = zero;
            if (n > 0 || kt >= 4) {
                const bf16* kp = Kb + (ptrdiff_t)(32 * kt) * KVW;
                bf16x8 ak[4];
#pragma unroll
                for (int st = 0; st < 4; ++st) ak[st] = *(const bf16x8*)(kp + 16 * st);
#pragma unroll
                for (int st = 0; st < 4; ++st) S[kj] = MFMA32(ak[st], bq[st], S[kj]);
            }
        }
        float mx = sink;
#pragma unroll
        for (int kj = 0; kj < 5; ++kj) { const bool tv = (n > 0 || qi + kj >= 4);
#pragma unroll
            for (int i = 0; i < 16; ++i) { const int kr = (i & 3) + 8 * (i >> 2) + 4 * h;
                const bool valid = tv && (kj == 0 ? (kr > r) : (kj == 4 ? (kr <= r) : true));
                const float sv = valid ? S[kj][i] : -INFINITY; S[kj][i] = sv; mx = fmaxf(mx, sv); } }
        mx = fmaxf(mx, __shfl_xor(mx, 32));
        float l = 0.f;
#pragma unroll
        for (int kj = 0; kj < 5; ++kj)
#pragma unroll
            for (int i = 0; i < 16; ++i) { const float pv = __builtin_amdgcn_exp2f((S[kj][i] - mx) * LOG2E); S[kj][i] = pv; l += pv; }
        l += __shfl_xor(l, 32); l += __builtin_amdgcn_exp2f((sink - mx) * LOG2E);
        const float inv = 1.0f / l;
        f32x16 O[2] = {zero, zero};
#pragma unroll
        for (int kj = 0; kj < 5; ++kj) { const int kt = qi + kj;
            if (n > 0 || kt >= 4) {
#pragma unroll
                for (int s = 0; s < 2; ++s) {
                    u32x4 pw; pw.x = pk(S[kj][8 * s], S[kj][8 * s + 1]); pw.y = pk(S[kj][8 * s + 2], S[kj][8 * s + 3]); pw.z = pk(S[kj][8 * s + 4], S[kj][8 * s + 5]); pw.w = pk(S[kj][8 * s + 6], S[kj][8 * s + 7]);
                    const bf16x8 pb = __builtin_bit_cast(bf16x8, pw);
#pragma unroll
                    for (int dt = 0; dt < 2; ++dt) { const bf16* vp = Vb + (ptrdiff_t)(32 * dt) * SEQ + 32 * kt + 16 * s;
                        const s16x4 lo = *(const s16x4*)vp, hi = *(const s16x4*)(vp + 8);
                        const bf16x8 av = __builtin_shufflevector(lo, hi, 0, 1, 2, 3, 4, 5, 6, 7);
                        O[dt] = MFMA32(av, pb, O[dt]); }
                }
            }
        }
        bf16* op = ATT + (tok0 + 32 * qi + r) * QW + hq * 64 + 4 * h;
#pragma unroll
        for (int dt = 0; dt < 2; ++dt)
#pragma unroll
            for (int g = 0; g < 4; ++g) { u32x2 w; w.x = pk(O[dt][4 * g] * inv, O[dt][4 * g + 1] * inv); w.y = pk(O[dt][4 * g + 2] * inv, O[dt][4 * g + 3] * inv); *(u32x2*)(op + 32 * dt + 8 * g) = w; }
    }
}
DI void conv_mixer(const Params& p, int gw, int NGW, int lane) {
    const bf16* CB = (const bf16*)(p.ws + WS_CB); const bf16* P = (const bf16*)(p.ws + WS_P); bf16* H = (bf16*)(p.ws + WS_U);
    f32x4 w[2][3][2];
#pragma unroll
    for (int j = 0; j < 2; ++j)
#pragma unroll
        for (int t = 0; t < 3; ++t)
#pragma unroll
            for (int hh = 0; hh < 2; ++hh) w[j][t][hh] = *(const f32x4*)(p.conv_mix_w + t * DM + 512 * j + lane * 8 + 4 * hh);
    const u32x4 z = {0u, 0u, 0u, 0u};
    for (int row = gw; row < M; row += NGW) { const int s = row & (SEQ - 1);
#pragma unroll
        for (int j = 0; j < 2; ++j) { const size_t off = (size_t)row * DM + 512 * j + lane * 8;
            const u32x4 c = *(const u32x4*)(CB + off), p0 = *(const u32x4*)(P + off);
            const u32x4 p1 = s >= 1 ? *(const u32x4*)(P + off - DM) : z, p2 = s >= 2 ? *(const u32x4*)(P + off - 2 * DM) : z;
            const f32x4 lo = unlo(c) * (w[j][0][0] * unlo(p2) + w[j][1][0] * unlo(p1) + w[j][2][0] * unlo(p0));
            const f32x4 hi = unhi(c) * (w[j][0][1] * unhi(p2) + w[j][1][1] * unhi(p1) + w[j][2][1] * unhi(p0));
            *(u32x4*)(H + off) = pk8(lo, hi); } }
}

__global__ void __launch_bounds__(NWAVES * 64, 2) mega_fwd(Params p) {
    extern __shared__ __attribute__((aligned(16))) unsigned char lds_raw[];
    cg::grid_group grid = cg::this_grid();
    LAS unsigned char* lds = (LAS unsigned char*)lds_raw;
    const int tid = threadIdx.x, lane = tid & 63, wave = __builtin_amdgcn_readfirstlane(tid >> 6);
    const int G = gridDim.x, gw = blockIdx.x * NWAVES + wave, NGW = G * NWAVES;
    unsigned char* ws = p.ws;
    bf16* const Ub = (bf16*)(ws + WS_U); bf16* const CBb = (bf16*)(ws + WS_CB); bf16* const Pb = (bf16*)(ws + WS_P);
    bf16* const SGC = (bf16*)(ws + WS_SGC); bf16* const SGA = (bf16*)(ws + WS_SGA);
    bf16* const Qb = (bf16*)(ws + WS_Q); bf16* const Kb = (bf16*)(ws + WS_K); bf16* const VTb = (bf16*)(ws + WS_VT); bf16* const ATT = (bf16*)(ws + WS_ATT);
    float* const SS1 = (float*)(ws + WS_SS1); float* const SS2 = (float*)(ws + WS_SS2);

    prologue(p, lds, wave, lane);
    grid.sync();
    { pg8::Gemm g{Ub, (const bf16*)(ws + WS_WIN), M, NIN, DM}; pg8::StaticOrder S; S.init(M, NIN, G, (int)blockIdx.x);
      Epi1 E{(const float*)(ws + WS_BIAS1), CBb, Pb, Qb, Kb, VTb, SGC, SGA, (const float*)(ws + WS_RC), (const float*)(ws + WS_RS)};
      pg8::gemm_phase<Epi1, pg8::StaticOrder, true, true>(lds, g, S, E); }
    grid.sync();
    for (int u = gw; u < BATCH * 64 * 8; u += NGW) attn_unit(Qb, Kb, VTb, ATT, p.sinks, u, lane);
    conv_mixer(p, gw, NGW, lane);
    grid.sync();
    { pg8::Gemm g{Ub  , (const bf16*)(ws + WS_WCONV), M, DM, DM}; pg8::StaticOrder S; S.init(M, DM, G, (int)blockIdx.x);
      Epi2a E{SGC, CBb  };
      pg8::gemm_phase<Epi2a, pg8::StaticOrder, true, true>(lds, g, S, E); }
    __syncthreads();
    { pg8::Gemm g{ATT, (const bf16*)(ws + WS_WATT), M, DM, QW}; pg8::StaticOrder S; S.init(M, DM, G, (int)blockIdx.x);
      Epi2b E{SGA, CBb  , p.b_attn_out, Pb  };
      pg8::gemm_phase<Epi2b, pg8::StaticOrder, true, true>(lds, g, S, E); }
    grid.sync();
    { pg8::Gemm g{Pb  , (const bf16*)(ws + WS_WMIX), M, DM, DM}; pg8::StaticOrder S; S.init(M, DM, G, (int)blockIdx.x);
      EpiRes<true> E{p.x, p.out, Ub  , SS1};
      pg8::gemm_phase<EpiRes<true>, pg8::StaticOrder, true, true>(lds, g, S, E); }
    grid.sync();
    { pg8::Gemm g{Ub  , (const bf16*)(ws + WS_WUP), M, NUP, DM}; pg8::StaticOrder S; S.init(M, NUP, G, (int)blockIdx.x);
      Epi4 E{SS1, p.ffn_conv_w, p.ffn_conv_b, CBb  , (float*)(ws + WS_UPH), (float*)(ws + WS_GH)};
      pg8::gemm_phase<Epi4, pg8::StaticOrder, true, true>(lds, g, S, E); }
    grid.sync();
    { const float* UPH = (const float*)(ws + WS_UPH); const float* GH = (const float*)(ws + WS_GH); bf16* H2 = CBb;
      for (int idx = gw * 64 + lane; idx < 512 * 2 * (DFF / 4); idx += NGW * 64) {
          const int c4 = idx % (DFF / 4), rr = (idx / (DFF / 4)) & 1, chunk = idx / (2 * (DFF / 4)), ch = 4 * c4;
          const bool first = (chunk & 127) == 0; const f32x4 z = {0.f, 0.f, 0.f, 0.f};
          const f32x4 cur = *(const f32x4*)(UPH + ((size_t)chunk * 4 + 2 + rr) * DFF + ch);
          f32x4 p1, p2;
          if (rr == 0) { p1 = first ? z : *(const f32x4*)(UPH + ((size_t)(chunk - 1) * 4 + 1) * DFF + ch); p2 = first ? z : *(const f32x4*)(UPH + ((size_t)(chunk - 1) * 4 + 0) * DFF + ch); }
          else { p1 = *(const f32x4*)(UPH + ((size_t)chunk * 4 + 2) * DFF + ch); p2 = first ? z : *(const f32x4*)(UPH + ((size_t)(chunk - 1) * 4 + 1) * DFF + ch); }
          const f32x4 gate = *(const f32x4*)(GH + ((size_t)chunk * 2 + rr) * DFF + ch);
          const f32x4 a = *(const f32x4*)(p.ffn_conv_w + 2 * DFF + ch) * cur + *(const f32x4*)(p.ffn_conv_w + DFF + ch) * p1 + *(const f32x4*)(p.ffn_conv_w + ch) * p2 + *(const f32x4*)(p.ffn_conv_b + ch);
          const f32x4 hv = a * sig4(a) * gate;
          u32x2 w; w.x = pk(hv[0], hv[1]); w.y = pk(hv[2], hv[3]);
          *(u32x2*)(H2 + (size_t)(chunk * 64 + rr) * DFF + ch) = w; } }
    grid.sync();
    { pg8::Gemm g{CBb  , (const bf16*)(ws + WS_WDOWN), M, DM, DFF}; pg8::StaticOrder S; S.init(M, DM, G, (int)blockIdx.x);
      EpiRes<false> E{p.out, p.out, nullptr, SS2};
      pg8::gemm_phase<EpiRes<false>, pg8::StaticOrder, true, true>(lds, g, S, E); }
    grid.sync();
    { f32x4 wv[4];
#pragma unroll
      for (int j = 0; j < 4; ++j) wv[j] = *((const f32x4*)p.norm_final_w + lane + 64 * j);
      for (int m = gw; m < M; m += NGW) { f32x4* xr = (f32x4*)(p.out + (size_t)m * DM) + lane; const float rstd = __builtin_amdgcn_rsqf(SS2[m] * (1.0f / DM) + EPS);
#pragma unroll
          for (int j = 0; j < 4; ++j) xr[64 * j] = xr[64 * j] * rstd * wv[j]; } }
}

extern "C" void kernel_launch(void* const* d_in, const int* in_sizes, int n_in, void* d_out, int out_size, void* d_ws, size_t ws_size, hipStream_t stream) {
    static int grid = 0;
    if (grid == 0) {
        if (n_in != 17 || in_sizes[0] != M * DM || out_size != M * DM || ws_size < WS_END) { fprintf(stderr, "kernel_launch: unexpected shapes / workspace (%d inputs, ws %zu)\n", n_in, ws_size); grid = -1; return; }
        int dev = 0, cus = 0, per_cu = 0;
        if (hipGetDevice(&dev) != hipSuccess || hipDeviceGetAttribute(&cus, hipDeviceAttributeMultiprocessorCount, dev) != hipSuccess) { grid = -1; return; }
        if (hipFuncSetAttribute((const void*)mega_fwd, hipFuncAttributeMaxDynamicSharedMemorySize, LDS_BYTES) != hipSuccess) { fprintf(stderr, "kernel_launch: hipFuncSetAttribute failed\n"); grid = -1; return; }
        if (hipOccupancyMaxActiveBlocksPerMultiprocessor(&per_cu, (const void*)mega_fwd, NWAVES * 64, LDS_BYTES) != hipSuccess || per_cu < 1) { fprintf(stderr, "kernel_launch: occupancy query says %d\n", per_cu); (void)hipGetLastError(); grid = -1; return; }
        grid = cus;
    }
    if (grid < 0) return;
    Params p{};
    p.x = (const float*)d_in[0]; p.pos = (const int*)d_in[1]; p.norm_mix_w = (const float*)d_in[2]; p.w_in = (const float*)d_in[3]; p.b_in = (const float*)d_in[4];
    p.conv_mix_w = (const float*)d_in[5]; p.w_conv_out = (const float*)d_in[6]; p.w_attn_out = (const float*)d_in[7]; p.b_attn_out = (const float*)d_in[8]; p.sinks = (const float*)d_in[9];
    p.w_mix_out = (const float*)d_in[10]; p.norm_ffn_w = (const float*)d_in[11]; p.w_ffn_up = (const float*)d_in[12]; p.ffn_conv_w = (const float*)d_in[13]; p.ffn_conv_b = (const float*)d_in[14];
    p.w_ffn_down = (const float*)d_in[15]; p.norm_final_w = (const float*)d_in[16]; p.out = (float*)d_out; p.ws = (unsigned char*)d_ws;
    void* args[] = {&p};
    hipError_t e = hipLaunchCooperativeKernel((const void*)mega_fwd, dim3(grid), dim3(NWAVES * 64), args, LDS_BYTES, stream);
    if (e != hipSuccess) fprintf(stderr, "cooperative launch failed: %s (grid %d)\n", hipGetErrorString(e), grid);
}
```

```cpp
#include <hip/hip_runtime.h>
#include <hip/hip_cooperative_groups.h>
#include <cstdio>
#include <cstdint>
#include <cstddef>
namespace cg = cooperative_groups;
namespace pg8 {
#define PG8_LAS __attribute__((address_space(3)))
typedef unsigned short bf16_t;
typedef short bf16x8 __attribute__((ext_vector_type(8)));
typedef float f32x4 __attribute__((ext_vector_type(4)));
typedef unsigned u32x4 __attribute__((ext_vector_type(4)));
constexpr int BM = 256, BK = 64, HALF = 128, HTB = HALF * BK * 2  , STAGE_BYTES = 8 * HTB, NXCD = 8, WGM = 8;

__host__ __device__ __forceinline__ int lds_byte(int r, int c) { const int st = (r >> 4) * 2 + (c >> 5), rr = r & 15, cc = c & 31, ob = rr * 64 + cc * 2; return st * 1024 + (ob ^ (((ob >> 9) & 1) << 5)); }
__host__ __device__ __forceinline__ void stage_rc(int b, int& R, int& C) { const int st = b / 1024, sb = b % 1024, swz = sb ^ (((sb >> 9) & 1) << 5); R = (st >> 1) * 16 + swz / 64; C = (st & 1) * 32 + (swz % 64) / 2; }
__host__ __device__ __forceinline__ int perm32(int rho) { const int n = rho >> 4, i = rho & 15; return 8 * (i >> 2) + 4 * n + (i & 3); }

struct Unit { int pm, pn; };
struct Gemm { const bf16_t* A; const bf16_t* Bt; int M, N, K; };

struct StaticOrder {
    int nM, nN, nwg, G, c;
    __host__ __device__ void init(int M, int N, int G_, int c_) { nM = M / BM; nN = N / BM; nwg = nM * nN; G = G_; c = c_; }
    __host__ __device__ bool next(int i, Unit& u) const {
        const long L = (long)i * G + c; if (L >= nwg) return false;
        int wgid = (int)L; { const int q = nwg / NXCD, r = nwg % NXCD, xcd = wgid % NXCD, off = wgid / NXCD; wgid = (xcd < r ? xcd * (q + 1) : r * (q + 1) + (xcd - r) * q) + off; }
        const int nig = WGM * nN, gid = wgid / nig, fm = gid * WGM, gsz = (nM - fm) < WGM ? (nM - fm) : WGM;
        u.pm = fm + ((wgid % nig) % gsz); u.pn = (wgid % nig) / gsz; return true;
    }
    __device__ __forceinline__ void a_ready(const Unit&) const {}
    __device__ __forceinline__ void done(const Unit&) const {}
};

__device__ __forceinline__ unsigned cvt_pk_bf16(float lo, float hi) { unsigned r; asm volatile("v_cvt_pk_bf16_f32 %0, %1, %2" : "=v"(r) : "v"(lo), "v"(hi)); return r; }
template <class Epi, class Sched, bool ALIGN_EPI = false, bool SP2 = false>
__device__ __forceinline__ void gemm_phase(PG8_LAS unsigned char* lds, const Gemm g, const Sched& S, const Epi& E) {
    int tid_ = threadIdx.x; asm volatile("" : "+v"(tid_));
    const int tid = tid_, wid = __builtin_amdgcn_readfirstlane(tid >> 6), lane = tid & 63, wr = wid >> 2, wc = wid & 3, fr = lane & 15, fq = lane >> 4;
    const int K = g.K, nt = K / BK;
    unsigned voffA[2], voffB[2];
#pragma unroll
    for (int i = 0; i < 2; ++i) { int R, C; stage_rc(tid * 16 + i * 8192, R, C); const int Rb = Epi::PERM ? ((R & ~31) + perm32(R & 31)) : R;
        voffA[i] = (unsigned)(R * K + C) * 2u; voffB[i] = (unsigned)(Rb * K + C) * 2u; }
    const size_t kstep = (size_t)(BK * 2);
    const size_t hstep = (size_t)HALF * K * 2;
    const size_t tstep = 2 * hstep;
    const unsigned ldsw = (unsigned)wid * 1024u;
    const int aoff = lds_byte(wr * 64 + fr, fq * 8), boff = lds_byte(wc * 32 + fr, fq * 8);
#define PG8_SA(b, h) (((b) * 2 + (h)) * HTB)
#define PG8_SB(b, h) ((4 + (b) * 2 + (h)) * HTB)
#define PG8_STAGE(bufoff, gbase, voff) do { _Pragma("unroll") for (int _i = 0; _i < 2; ++_i) \
        __builtin_amdgcn_global_load_lds((const unsigned*)((const char*)(gbase) + (voff)[_i]), (PG8_LAS unsigned*)(lds + (bufoff) + ldsw + _i * 8192), 16, 0, 0); } while (0)
#define PG8_LDA(dst, b, h) do { _Pragma("unroll") for (int m = 0; m < 4; ++m) _Pragma("unroll") for (int k = 0; k < 2; ++k) dst[m][k] = *(const PG8_LAS bf16x8*)(lds + PG8_SA(b, h) + aoff + m * 2048 + k * 1024); } while (0)
#define PG8_LDB(dst, b, h) do { _Pragma("unroll") for (int n = 0; n < 2; ++n) _Pragma("unroll") for (int k = 0; k < 2; ++k) dst[n][k] = *(const PG8_LAS bf16x8*)(lds + PG8_SB(b, h) + boff + n * 2048 + k * 1024); } while (0)
#define PG8_MMA(ai, bj, At, Bt) do { __builtin_amdgcn_s_setprio(1); _Pragma("unroll") for (int m = 0; m < 4; ++m) _Pragma("unroll") for (int n = 0; n < 2; ++n) _Pragma("unroll") for (int k = 0; k < 2; ++k) \
        acc[ai][bj][m][n] = __builtin_amdgcn_mfma_f32_16x16x32_bf16(Bt[n][k], At[m][k], acc[ai][bj][m][n], 0, 0, 0); __builtin_amdgcn_s_setprio(0); } while (0)
#define PG8_WAIT_V(n) asm volatile("s_waitcnt vmcnt(" #n ")" ::: "memory")
#define PG8_WAIT_L(n) asm volatile("s_waitcnt lgkmcnt(" #n ")" ::: "memory")
#define PG8_BAR __builtin_amdgcn_s_barrier()
#define PG8_SCHED __builtin_amdgcn_sched_barrier(0)
    Unit cur, nxt; int ui = 0;
    if (!S.next(0, cur)) return;
    f32x4 acc[2][2][4][2];
#pragma unroll
    for (int a = 0; a < 2; ++a)
#pragma unroll
        for (int b = 0; b < 2; ++b)
#pragma unroll
            for (int m = 0; m < 4; ++m)
#pragma unroll
                for (int n = 0; n < 2; ++n) acc[a][b][m][n] = (f32x4){0.f, 0.f, 0.f, 0.f};
    bf16x8 At[4][2], B0[2][2], B1[2][2];
    const char* cA = (const char*)g.A + (size_t)cur.pm * tstep; const char* cB = (const char*)g.Bt + (size_t)cur.pn * tstep;
    S.a_ready(cur);
    if constexpr (SP2) {
        PG8_STAGE(PG8_SB(0, 0), cB, voffB); PG8_STAGE(PG8_SB(0, 1), cB + hstep, voffB); PG8_STAGE(PG8_SA(0, 0), cA, voffA); PG8_STAGE(PG8_SA(0, 1), cA + hstep, voffA);
        if (wr == 1) PG8_BAR;
        PG8_WAIT_V(2); PG8_BAR;
        PG8_STAGE(PG8_SB(1, 0), cB + kstep, voffB); PG8_STAGE(PG8_SA(1, 0), cA + kstep, voffA); PG8_STAGE(PG8_SB(1, 1), cB + hstep + kstep, voffB);
        PG8_WAIT_V(6); PG8_BAR;
    } else {
        PG8_STAGE(PG8_SB(0, 0), cB, voffB); PG8_STAGE(PG8_SA(0, 0), cA, voffA); PG8_STAGE(PG8_SB(0, 1), cB + hstep, voffB); PG8_STAGE(PG8_SA(0, 1), cA + hstep, voffA);
        if (wr == 1) PG8_BAR;
        PG8_WAIT_V(4); PG8_BAR;
        PG8_STAGE(PG8_SB(1, 0), cB + kstep, voffB); PG8_STAGE(PG8_SA(1, 0), cA + kstep, voffA); PG8_STAGE(PG8_SB(1, 1), cB + hstep + kstep, voffB);
        PG8_WAIT_V(6); PG8_BAR;
    }
    for (;;) {
        const bool has_next = S.next(ui + 1, nxt);
        const char* nA = has_next ? (const char*)g.A + (size_t)nxt.pm * tstep : cA; const char* nB = has_next ? (const char*)g.Bt + (size_t)nxt.pn * tstep : cB;
        for (int t = 0; t < nt; t += 2) {
            const bool last = (t == nt - 2);
            const char* a1 = cA + (size_t)(t + 1) * kstep;
            const char* a2 = last ? nA : cA + (size_t)(t + 2) * kstep; const char* b2 = last ? nB : cB + (size_t)(t + 2) * kstep;
            const char* a3 = a2 + kstep; const char* b3 = b2 + kstep;
            if (last && has_next) S.a_ready(nxt);
            if constexpr (SP2) {
            PG8_LDB(B0, 0, 0); PG8_LDB(B1, 0, 1); PG8_SCHED; PG8_LDA(At, 0, 0); PG8_STAGE(PG8_SA(1, 1), a1 + hstep, voffA);
            PG8_WAIT_V(8); PG8_WAIT_L(0); PG8_BAR; PG8_MMA(0, 0, At, B0); PG8_MMA(0, 1, At, B1); PG8_BAR; PG8_SCHED;
            PG8_LDA(At, 0, 1); PG8_STAGE(PG8_SB(0, 0), b2, voffB); PG8_STAGE(PG8_SB(0, 1), b2 + hstep, voffB); PG8_STAGE(PG8_SA(0, 0), a2, voffA);
            PG8_WAIT_V(8); PG8_WAIT_L(0); PG8_BAR; PG8_MMA(1, 0, At, B0); PG8_MMA(1, 1, At, B1); PG8_BAR; PG8_SCHED;
            PG8_LDB(B0, 1, 0); PG8_LDB(B1, 1, 1); PG8_SCHED; PG8_LDA(At, 1, 0); PG8_STAGE(PG8_SA(0, 1), a2 + hstep, voffA);
            PG8_WAIT_V(8); PG8_WAIT_L(0); PG8_BAR; PG8_MMA(0, 0, At, B0); PG8_MMA(0, 1, At, B1); PG8_BAR; PG8_SCHED;
            PG8_LDA(At, 1, 1); PG8_STAGE(PG8_SB(1, 0), b3, voffB); PG8_STAGE(PG8_SB(1, 1), b3 + hstep, voffB); PG8_STAGE(PG8_SA(1, 0), a3, voffA);
            PG8_WAIT_V(8); PG8_WAIT_L(0); PG8_BAR; PG8_MMA(1, 0, At, B0); PG8_MMA(1, 1, At, B1); PG8_BAR; PG8_SCHED;
            } else {
            PG8_LDB(B0, 0, 0); PG8_SCHED; PG8_LDA(At, 0, 0); PG8_STAGE(PG8_SA(1, 1), a1 + hstep, voffA);
            PG8_WAIT_L(8); PG8_BAR; PG8_WAIT_L(0); PG8_MMA(0, 0, At, B0); PG8_BAR; PG8_SCHED;
            PG8_LDB(B1, 0, 1); PG8_STAGE(PG8_SB(0, 0), b2, voffB);
            PG8_BAR; PG8_WAIT_L(0); PG8_MMA(0, 1, At, B1); PG8_BAR;
            PG8_LDA(At, 0, 1); PG8_STAGE(PG8_SA(0, 0), a2, voffA);
            PG8_BAR; PG8_WAIT_L(0); PG8_MMA(1, 0, At, B0); PG8_BAR; PG8_SCHED;
            PG8_STAGE(PG8_SB(0, 1), b2 + hstep, voffB);
            PG8_WAIT_V(6); PG8_BAR; PG8_MMA(1, 1, At, B1); PG8_BAR;
            PG8_LDB(B0, 1, 0); PG8_SCHED; PG8_LDA(At, 1, 0); PG8_STAGE(PG8_SA(0, 1), a2 + hstep, voffA);
            PG8_WAIT_L(8); PG8_BAR; PG8_WAIT_L(0); PG8_MMA(0, 0, At, B0); PG8_BAR; PG8_SCHED;
            PG8_LDB(B1, 1, 1); PG8_STAGE(PG8_SB(1, 0), b3, voffB);
            PG8_BAR; PG8_WAIT_L(0); PG8_MMA(0, 1, At, B1); PG8_BAR;
            PG8_LDA(At, 1, 1); PG8_STAGE(PG8_SA(1, 0), a3, voffA);
            PG8_BAR; PG8_WAIT_L(0); PG8_MMA(1, 0, At, B0); PG8_BAR; PG8_SCHED;
            PG8_STAGE(PG8_SB(1, 1), b3 + hstep, voffB);
            PG8_WAIT_V(6); PG8_BAR; PG8_MMA(1, 1, At, B1); PG8_BAR;
            }
        }
        if constexpr (ALIGN_EPI) { if (wr == 0) PG8_BAR; }
        if constexpr (!Epi::AFTER_DRAIN) { E(acc, cur, wr, wc, fr, fq); S.done(cur); }
        if (!has_next) break;
#pragma unroll
        for (int a = 0; a < 2; ++a)
#pragma unroll
            for (int b = 0; b < 2; ++b)
#pragma unroll
                for (int m = 0; m < 4; ++m)
#pragma unroll
                    for (int n = 0; n < 2; ++n) acc[a][b][m][n] = (f32x4){0.f, 0.f, 0.f, 0.f};
        cur = nxt; cA = nA; cB = nB; ++ui;
        if constexpr (ALIGN_EPI) { if (wr == 1) PG8_BAR; }
    }
    PG8_WAIT_V(0);
    if constexpr (!ALIGN_EPI) { if (wr == 0) PG8_BAR; }
    PG8_BAR;
    if constexpr (Epi::AFTER_DRAIN) { E.fused(acc, cur, wr, wc, fr, fq, lds, wid, lane); S.done(cur); }
#undef PG8_SA
#undef PG8_SB
#undef PG8_STAGE
#undef PG8_LDA
#undef PG8_LDB
#undef PG8_MMA
#undef PG8_WAIT_V
#undef PG8_WAIT_L
#undef PG8_BAR
#undef PG8_SCHED
}
}
#ifndef PROBE_DUP
#define PROBE_DUP -1
#endif
#define REP(k) for (int rep_ = 0; rep_ < ((PROBE_DUP == (k)) ? 2 : 1); ++rep_)
#define DI __device__ __forceinline__
#define LAS __attribute__((address_space(3)))
typedef unsigned short bf16;
typedef float f32x4 __attribute__((ext_vector_type(4)));
typedef float f32x16 __attribute__((ext_vector_type(16)));
typedef unsigned u32x4 __attribute__((ext_vector_type(4)));
typedef unsigned u32x2 __attribute__((ext_vector_type(2)));
typedef short bf16x8 __attribute__((ext_vector_type(8)));
typedef short s16x4 __attribute__((ext_vector_type(4)));
typedef float f32x2_t __attribute__((ext_vector_type(2)));
typedef __bf16 bf16x2_t __attribute__((ext_vector_type(2)));

constexpr int NWAVES = 8;
constexpr int DM = 1024, BATCH = 4, SEQ = 8192, M = BATCH * SEQ;
constexpr int NIN = 5888, QW = 512, KVW = 128, DFF = 2816, NUP = 2 * DFF;
constexpr float EPS = 1e-5f;
constexpr float LOG2E = 1.4426950408889634f;
constexpr int LDS_BYTES = 147456, LDS_MISC = 131072;

constexpr size_t MiB = 1u << 20;
constexpr size_t WS_SS1 = 0, WS_SS2 = 128 * 1024, WS_BIAS1 = 256 * 1024, WS_BAR = 512 * 1024, BAR_BYTES = 16384;
constexpr size_t WS_RC = 1 * MiB, WS_RS = 5 * MiB;
constexpr size_t WS_WIN = 9 * MiB;
constexpr size_t WS_WCONV = WS_WIN + (size_t)NIN * DM * 2;
constexpr size_t WS_WATT = WS_WCONV + (size_t)DM * DM * 2;
constexpr size_t WS_WMIX = WS_WATT + (size_t)DM * QW * 2;
constexpr size_t WS_WUP = WS_WMIX + (size_t)DM * DM * 2;
constexpr size_t WS_WDOWN = WS_WUP + (size_t)NUP * DM * 2;
static_assert(WS_WDOWN + (size_t)DM * DFF * 2 <= 48 * MiB, "weights");
constexpr size_t WS_U = 48 * MiB;
constexpr size_t WS_CB = 112 * MiB;
constexpr size_t WS_P = 176 * MiB;
constexpr size_t WS_SGC = 240 * MiB, WS_SGA = 304 * MiB;
constexpr size_t WS_Q = 368 * MiB, WS_K = 400 * MiB, WS_VT = 408 * MiB, WS_ATT = 416 * MiB;
constexpr size_t WS_UPH = 368 * MiB, WS_GH = 392 * MiB;
constexpr size_t WS_END = 448 * MiB;
static_assert((size_t)512 * 4 * DFF * 4 <= 24 * MiB && (size_t)512 * 2 * DFF * 4 <= 16 * MiB, "halo");

DI unsigned pk(float lo, float hi) { f32x2_t v = {lo, hi}; bf16x2_t b = __builtin_convertvector(v, bf16x2_t); return __builtin_bit_cast(unsigned, b); }
DI u32x4 pk8(f32x4 a, f32x4 b) { u32x4 w; w.x = pk(a[0], a[1]); w.y = pk(a[2], a[3]); w.z = pk(b[0], b[1]); w.w = pk(b[2], b[3]); return w; }
DI f32x4 unlo(u32x4 w) { return (f32x4){__uint_as_float(w.x << 16), __uint_as_float(w.x & 0xffff0000u), __uint_as_float(w.y << 16), __uint_as_float(w.y & 0xffff0000u)}; }
DI f32x4 unhi(u32x4 w) { return (f32x4){__uint_as_float(w.z << 16), __uint_as_float(w.z & 0xffff0000u), __uint_as_float(w.w << 16), __uint_as_float(w.w & 0xffff0000u)}; }
DI float sigmoidf_(float x) { return __builtin_amdgcn_rcpf(1.0f + __builtin_amdgcn_exp2f(-x * LOG2E)); }
DI f32x4 sig4(f32x4 v) { return (f32x4){sigmoidf_(v[0]), sigmoidf_(v[1]), sigmoidf_(v[2]), sigmoidf_(v[3])}; }
DI float dpp_ror1(float s) { return __int_as_float(__builtin_amdgcn_update_dpp(0, __float_as_int(s), 0x121, 0xf, 0xf, false)); }
DI float dpp_ror2(float s) { return __int_as_float(__builtin_amdgcn_update_dpp(0, __float_as_int(s), 0x122, 0xf, 0xf, false)); }
DI float dpp_shr1(float old, float s) { return __int_as_float(__builtin_amdgcn_update_dpp(__float_as_int(old), __float_as_int(s), 0x111, 0xf, 0xf, false)); }
DI float dpp_shr2(float old, float s) { return __int_as_float(__builtin_amdgcn_update_dpp(__float_as_int(old), __float_as_int(s), 0x112, 0xf, 0xf, false)); }

__host__ __device__ inline int src_col_in(int n) {
    const int pn = n >> 8, c = n & 255, bj = c >> 7, cc = c & 127;
    if (pn < 4) return n;
    if (pn < 12) return (bj ? 2048 : 1024) + 128 * (pn - 4) + cc;
    if (pn < 14) return 3072 + (4 * (pn - 12) + (cc >> 5)) * 64 + (cc & 31) + 32 * bj;
    if (pn == 14) { const int w = cc >> 5, dd = cc & 31; return w < 2 ? 3584 + w * 64 + dd + 32 * bj : 3712 + bj * 64 + 32 * (w - 2) + dd; }
    if (pn < 19) return 3840 + (n - 15 * 256);
    return 4864 + (n - 19 * 256);
}
__host__ __device__ inline int src_col_up(int n) { const int pn = n >> 8, c = n & 255; return ((c >> 7) ? DFF : 0) + 128 * pn + (c & 127); }

using pg8::Unit;
struct Epi1 {
    static constexpr bool PERM = true, AFTER_DRAIN = false;
    const float* bias; bf16 *CB, *P, *Q, *K, *VT, *SGC, *SGA; const float *RC, *RS;
    DI void operator()(const f32x4 (&acc)[2][2][4][2], const Unit& u, int wr, int wc, int fr, int fq) const {
        const int pn = u.pn; const int row0 = u.pm * 256 + wr * 64 + fr; const int bcol0 = pn * 256 + wc * 32 + 8 * fq;
        f32x4 bv[2][2];
#pragma unroll
        for (int bj = 0; bj < 2; ++bj)
#pragma unroll
            for (int n = 0; n < 2; ++n) bv[bj][n] = *(const f32x4*)(bias + bcol0 + bj * 128 + 4 * n);
        if (pn < 4 || pn >= 15) {
            bf16* base; int colt; bool sig;
            if (pn < 4) { base = CB; colt = pn * 256; sig = false; } else if (pn < 19) { base = SGC; colt = (pn - 15) * 256; sig = true; } else { base = SGA; colt = (pn - 19) * 256; sig = true; }
            const int col0 = colt + wc * 32 + 8 * fq;
#pragma unroll
            for (int ai = 0; ai < 2; ++ai)
#pragma unroll
                for (int m = 0; m < 4; ++m) { bf16* rowp = base + (size_t)(row0 + ai * 128 + m * 16) * DM + col0;
#pragma unroll
                    for (int bj = 0; bj < 2; ++bj) { f32x4 v0 = acc[ai][bj][m][0] + bv[bj][0], v1 = acc[ai][bj][m][1] + bv[bj][1];
                        if (sig) { v0 = sig4(v0); v1 = sig4(v1); }
                        *(u32x4*)(rowp + bj * 128) = pk8(v0, v1); } }
        } else if (pn < 12) {
            const int col0 = (pn - 4) * 128 + wc * 32 + 8 * fq;
#pragma unroll
            for (int ai = 0; ai < 2; ++ai)
#pragma unroll
                for (int m = 0; m < 4; ++m) { bf16* rowp = P + (size_t)(row0 + ai * 128 + m * 16) * DM + col0;
                    const f32x4 p0 = (acc[ai][0][m][0] + bv[0][0]) * (acc[ai][1][m][0] + bv[1][0]), p1 = (acc[ai][0][m][1] + bv[0][1]) * (acc[ai][1][m][1] + bv[1][1]);
                    *(u32x4*)rowp = pk8(p0, p1); }
        } else if (pn < 14 || wc < 2) {
            bf16* base; int ld, hcol; float sc;
            if (pn < 14) { base = Q; ld = QW; hcol = ((pn - 12) * 4 + wc) * 64; sc = 0.125f; } else { base = K; ld = KVW; hcol = wc * 64; sc = 1.0f; }
#pragma unroll
            for (int ai = 0; ai < 2; ++ai)
#pragma unroll
                for (int m = 0; m < 4; ++m) { const int row = row0 + ai * 128 + m * 16;
                    const f32x4 c0 = *(const f32x4*)(RC + (size_t)row * 32 + 8 * fq), c1 = *(const f32x4*)(RC + (size_t)row * 32 + 8 * fq + 4);
                    const f32x4 s0 = *(const f32x4*)(RS + (size_t)row * 32 + 8 * fq), s1 = *(const f32x4*)(RS + (size_t)row * 32 + 8 * fq + 4);
                    const f32x4 a0 = acc[ai][0][m][0] + bv[0][0], a1 = acc[ai][0][m][1] + bv[0][1], b0 = acc[ai][1][m][0] + bv[1][0], b1 = acc[ai][1][m][1] + bv[1][1];
                    const f32x4 o10 = (a0 * c0 - b0 * s0) * sc, o11 = (a1 * c1 - b1 * s1) * sc, o20 = (b0 * c0 + a0 * s0) * sc, o21 = (b1 * c1 + a1 * s1) * sc;
                    bf16* rowp = base + (size_t)row * ld + hcol + 8 * fq;
                    *(u32x4*)rowp = pk8(o10, o11); *(u32x4*)(rowp + 32) = pk8(o20, o21); }
        } else {
#pragma unroll
            for (int ai = 0; ai < 2; ++ai)
#pragma unroll
                for (int m = 0; m < 4; ++m) { const int row = row0 + ai * 128 + m * 16; const int b = row >> 13, s = row & (SEQ - 1);
#pragma unroll
                    for (int bj = 0; bj < 2; ++bj)
#pragma unroll
                        for (int n = 0; n < 2; ++n) { const f32x4 v = acc[ai][bj][m][n] + bv[bj][n]; const unsigned w0 = pk(v[0], v[1]), w1 = pk(v[2], v[3]);
                            bf16* p = VT + ((size_t)((b * 2 + bj) * 64 + 32 * (wc - 2) + 8 * fq + 4 * n)) * SEQ + s;
                            p[0] = (bf16)(w0 & 0xffffu); p[SEQ] = (bf16)(w0 >> 16); p[2 * SEQ] = (bf16)(w1 & 0xffffu); p[3 * SEQ] = (bf16)(w1 >> 16); } }
        }
    }
};
struct Epi2a {
    static constexpr bool PERM = true, AFTER_DRAIN = false;
    const bf16* G; bf16* T;
    DI void operator()(const f32x4 (&acc)[2][2][4][2], const Unit& u, int wr, int wc, int fr, int fq) const {
        const int row0 = u.pm * 256 + wr * 64 + fr, col0 = u.pn * 256 + wc * 32 + 8 * fq;
#pragma unroll
        for (int ai = 0; ai < 2; ++ai)
#pragma unroll
            for (int m = 0; m < 4; ++m) { const size_t off = (size_t)(row0 + ai * 128 + m * 16) * DM + col0;
#pragma unroll
                for (int bj = 0; bj < 2; ++bj) { const u32x4 g = *(const u32x4*)(G + off + bj * 128);
                    *(u32x4*)(T + off + bj * 128) = pk8(acc[ai][bj][m][0] * unlo(g), acc[ai][bj][m][1] * unhi(g)); } }
    }
};
struct Epi2b {
    static constexpr bool PERM = true, AFTER_DRAIN = false;
    const bf16* G; const bf16* T; const float* bias; bf16* O;
    DI void operator()(const f32x4 (&acc)[2][2][4][2], const Unit& u, int wr, int wc, int fr, int fq) const {
        const int row0 = u.pm * 256 + wr * 64 + fr, col0 = u.pn * 256 + wc * 32 + 8 * fq;
        f32x4 bv[2][2];
#pragma unroll
        for (int bj = 0; bj < 2; ++bj)
#pragma unroll
            for (int n = 0; n < 2; ++n) bv[bj][n] = *(const f32x4*)(bias + col0 + bj * 128 + 4 * n);
#pragma unroll
        for (int ai = 0; ai < 2; ++ai)
#pragma unroll
            for (int m = 0; m < 4; ++m) { const size_t off = (size_t)(row0 + ai * 128 + m * 16) * DM + col0;
#pragma unroll
                for (int bj = 0; bj < 2; ++bj) { const u32x4 g = *(const u32x4*)(G + off + bj * 128); const u32x4 t = *(const u32x4*)(T + off + bj * 128);
                    *(u32x4*)(O + off + bj * 128) = pk8((acc[ai][bj][m][0] + bv[bj][0]) * unlo(g) + unlo(t), (acc[ai][bj][m][1] + bv[bj][1]) * unhi(g) + unhi(t)); } }
    }
};
template <bool WB> struct EpiRes {
    static constexpr bool PERM = false, AFTER_DRAIN = false;
    const float* base; float* out; bf16* XB; float* SS;
    DI void operator()(const f32x4 (&acc)[2][2][4][2], const Unit& u, int wr, int wc, int fr, int fq) const {
        const int row0 = u.pm * 256 + wr * 64 + fr, col0 = u.pn * 256 + wc * 32 + 4 * fq;
#pragma unroll
        for (int ai = 0; ai < 2; ++ai)
#pragma unroll
            for (int m = 0; m < 4; ++m) { const int row = row0 + ai * 128 + m * 16; const size_t off = (size_t)row * DM + col0; float ss = 0.f;
#pragma unroll
                for (int bj = 0; bj < 2; ++bj)
#pragma unroll
                    for (int n = 0; n < 2; ++n) { const size_t o2 = off + bj * 128 + n * 16; const f32x4 o = *(const f32x4*)(base + o2) + acc[ai][bj][m][n];
                        *(f32x4*)(out + o2) = o; ss += (o[0] * o[0] + o[1] * o[1]) + (o[2] * o[2] + o[3] * o[3]);
                        if (WB) { u32x2 w; w.x = pk(o[0], o[1]); w.y = pk(o[2], o[3]); *(u32x2*)(XB + o2) = w; } }
                ss += __shfl_xor(ss, 16); ss += __shfl_xor(ss, 32);
                if (fq == 0) atomicAdd(SS + row, ss); }
    }
};
struct Epi4 {
    static constexpr bool PERM = true, AFTER_DRAIN = false;
    const float* SS1; const float* cw; const float* cbias; bf16* H2; float* UPH; float* GH;
    DI void operator()(const f32x4 (&acc)[2][2][4][2], const Unit& u, int wr, int wc, int fr, int fq) const {
        const int ch0 = u.pn * 128 + wc * 32 + 8 * fq;
        f32x4 w0[2], w1[2], w2[2], bb[2];
#pragma unroll
        for (int n = 0; n < 2; ++n) { w0[n] = *(const f32x4*)(cw + ch0 + 4 * n); w1[n] = *(const f32x4*)(cw + DFF + ch0 + 4 * n); w2[n] = *(const f32x4*)(cw + 2 * DFF + ch0 + 4 * n); bb[n] = *(const f32x4*)(cbias + ch0 + 4 * n); }
#pragma unroll
        for (int ai = 0; ai < 2; ++ai) {
            const int chunk = u.pm * 4 + ai * 2 + wr;
            f32x4 prev[2] = {(f32x4){0.f, 0.f, 0.f, 0.f}, (f32x4){0.f, 0.f, 0.f, 0.f}};
#pragma unroll
            for (int m = 0; m < 4; ++m) {
                const int row = chunk * 64 + m * 16 + fr;
                const float rstd = __builtin_amdgcn_rsqf(SS1[row] * (1.0f / DM) + EPS);
                f32x4 hv[2];
#pragma unroll
                for (int n = 0; n < 2; ++n) {
                    const f32x4 up = acc[ai][0][m][n] * rstd, gate = acc[ai][1][m][n] * rstd;
                    f32x4 p1, p2;
#pragma unroll
                    for (int i = 0; i < 4; ++i) { p1[i] = dpp_shr1(dpp_ror1(prev[n][i]), up[i]); p2[i] = dpp_shr2(dpp_ror2(prev[n][i]), up[i]); }
                    const f32x4 a = w2[n] * up + w1[n] * p1 + w0[n] * p2 + bb[n];
                    hv[n] = a * sig4(a) * gate;
                    if (m == 3 && fr >= 14) *(f32x4*)(UPH + ((size_t)chunk * 4 + (fr - 14)) * DFF + ch0 + 4 * n) = up;
                    if (m == 0 && fr < 2) { *(f32x4*)(UPH + ((size_t)chunk * 4 + 2 + fr) * DFF + ch0 + 4 * n) = up; *(f32x4*)(GH + ((size_t)chunk * 2 + fr) * DFF + ch0 + 4 * n) = gate; }
                    prev[n] = up;
                }
                *(u32x4*)(H2 + (size_t)row * DFF + ch0) = pk8(hv[0], hv[1]);
            }
        }
    }
};

#define XB_TMO      128
#define XB_XCNT(j)  (256  + 64 * (j))
#define XB_XSUB(j)  (1280 + 64 * (j))
#define XB_XGEN(j)  (2304 + 64 * (j))
#define XB_TOP      3328
#define XB_TOPGEN   3392
#define XCD_BAR_WORDS 3456
#define XB_SPIN_CAP (1u << 18)

__device__ __forceinline__ unsigned xb_ld(unsigned* p)              { return __hip_atomic_load(p, __ATOMIC_RELAXED, __HIP_MEMORY_SCOPE_AGENT); }
__device__ __forceinline__ unsigned xb_add(unsigned* p, unsigned v) { return __hip_atomic_fetch_add(p, v, __ATOMIC_RELAXED, __HIP_MEMORY_SCOPE_AGENT); }
__device__ __forceinline__ unsigned xb_xcc_id() { return (unsigned)__builtin_amdgcn_s_getreg((3 << 11) | 20) & 0xFu; }
#define XB_SPIN(cond, bar) do { unsigned _sp = 0; while (cond) { __builtin_amdgcn_s_sleep(1); \
    if ((++_sp & 255u) == 0u) { if (xb_ld(&(bar)[XB_TMO])) break; if (_sp > XB_SPIN_CAP) { atomicAdd(&(bar)[XB_TMO], 1u); break; } } } } while (0)

struct XcdBarrier {
    unsigned* bar; unsigned x;
    volatile LAS unsigned* st;
};

__device__ __forceinline__ XcdBarrier xcd_barrier_post(unsigned* bar, volatile LAS unsigned* st) {
    XcdBarrier b; b.bar = bar; b.x = xb_xcc_id(); b.st = st;
    if (threadIdx.x == 0) (void)xb_add(&bar[XB_XCNT(b.x)], 1u);
    return b;
}
__device__ __forceinline__ void xcd_barrier_complete(unsigned* bar, unsigned x, unsigned& nloc, unsigned& nx) {
    const unsigned G = gridDim.x * gridDim.y * gridDim.z;
    unsigned sum, cnt, mine, sp = 0u;
    for (;;) {
        sum = 0u; cnt = 0u; mine = 0u;
#pragma unroll
        for (unsigned j = 0; j < 16; ++j) { const unsigned c = xb_ld(&bar[XB_XCNT(j)]); sum += c; cnt += (c > 0u) ? 1u : 0u; mine = (j == x) ? c : mine; }
        if (sum == G) break;
        __builtin_amdgcn_s_sleep(1);
        if ((++sp & 255u) == 0u) { if (xb_ld(&bar[XB_TMO])) break; if (sp > XB_SPIN_CAP) { atomicAdd(&bar[XB_TMO], 1u); break; } }
    }
    nloc = mine > 0u ? mine : 1u; nx = cnt > 0u ? cnt : 1u;
}

__device__ __forceinline__ void xcd_barrier(const XcdBarrier& b) {
    asm volatile("s_waitcnt vmcnt(0)" ::: "memory");
    __syncthreads();
    if (threadIdx.x == 0) {
        unsigned* bar = b.bar;
        __builtin_amdgcn_s_waitcnt(0);
        unsigned nloc = b.st[0], nx = b.st[1];
        if (nloc == 0u) { xcd_barrier_complete(bar, b.x, nloc, nx); b.st[0] = nloc; b.st[1] = nx; }
        const unsigned old = xb_add(&bar[XB_XSUB(b.x)], 1u);
        const unsigned gen = old / nloc;
        if (old + 1u == (gen + 1u) * nloc) {
            __builtin_amdgcn_fence(__ATOMIC_RELEASE, "agent");
            asm volatile("s_waitcnt vmcnt(0)" ::: "memory");
            const unsigned og = xb_add(&bar[XB_TOP], 1u);
            const unsigned tg = og / nx;
            if (og + 1u == (tg + 1u) * nx) xb_add(&bar[XB_TOPGEN], 1u);
            else XB_SPIN(xb_ld(&bar[XB_TOPGEN]) == tg, bar);
            __builtin_amdgcn_fence(__ATOMIC_ACQUIRE, "agent");
            xb_add(&bar[XB_XGEN(b.x)], 1u);
            asm volatile("s_waitcnt vmcnt(0)" ::: "memory");
        } else {
            XB_SPIN(xb_ld(&bar[XB_XGEN(b.x)]) == gen, bar);
            __builtin_amdgcn_fence(__ATOMIC_ACQUIRE, "agent");
            asm volatile("s_waitcnt vmcnt(0)" ::: "memory");
        }
    }
    __syncthreads();
}

struct Params {
    const float* x; const int* pos; const float* norm_mix_w; const float* w_in; const float* b_in; const float* conv_mix_w; const float* w_conv_out;
    const float* w_attn_out; const float* b_attn_out; const float* sinks; const float* w_mix_out; const float* norm_ffn_w; const float* w_ffn_up;
    const float* ffn_conv_w; const float* ffn_conv_b; const float* w_ffn_down; const float* norm_final_w; float* out; unsigned char* ws;
};

DI float wave_sum(float v) {
#pragma unroll
    for (int o = 1; o < 64; o <<= 1) v += __shfl_xor(v, o);
    return v;
}
struct TItem { const float* W; bf16* WT; const float* ks; int K, N, n0, sc0, k0; };
DI void titem_load(const TItem& t, f32x4 (&v)[8], int lane) {
    const int kr = lane >> 3, n4 = lane & 7;
#pragma unroll
    for (int i = 0; i < 8; ++i) v[i] = *(const f32x4*)(t.W + (size_t)(t.k0 + kr + 8 * i) * t.N + t.sc0 + 4 * n4);
}
DI void titem_finish(const TItem& t, f32x4 (&v)[8], LAS float* scr, int lane) {
    const int kr = lane >> 3, n4 = lane & 7;
#pragma unroll
    for (int i = 0; i < 8; ++i) { const int kk = kr + 8 * i; f32x4 x = v[i]; if (t.ks) x = x * t.ks[t.k0 + kk];
        scr[kk * 33 + 4 * n4 + 0] = x[0]; scr[kk * 33 + 4 * n4 + 1] = x[1]; scr[kk * 33 + 4 * n4 + 2] = x[2]; scr[kk * 33 + 4 * n4 + 3] = x[3]; }
    asm volatile("s_waitcnt lgkmcnt(0)" ::: "memory");
    const int c = lane & 7;
#pragma unroll
    for (int j = 0; j < 4; ++j) { const int n = (lane >> 3) + 8 * j; const LAS float* sp = scr + (8 * c) * 33 + n;
        u32x4 o; o.x = pk(sp[0 * 33], sp[1 * 33]); o.y = pk(sp[2 * 33], sp[3 * 33]); o.z = pk(sp[4 * 33], sp[5 * 33]); o.w = pk(sp[6 * 33], sp[7 * 33]);
        *(u32x4*)(t.WT + (size_t)(t.n0 + n) * t.K + t.k0 + 8 * c) = o; }
    asm volatile("s_waitcnt lgkmcnt(0)" ::: "memory");
}
constexpr int I_IN = (DM / 64) * (NIN / 32), I_CONV = (DM / 64) * (DM / 32), I_ATT = (QW / 64) * (DM / 32), I_MIX = I_CONV, I_UP = (DM / 64) * (NUP / 32), I_DOWN = (DFF / 64) * (DM / 32);
constexpr int I_LATE = I_CONV + I_ATT + I_MIX + I_UP + I_DOWN;
DI TItem titem_in(const Params& p, int r) { const int nb = r % (NIN / 32), kb = r / (NIN / 32); return TItem{p.w_in, (bf16*)(p.ws + WS_WIN), nullptr, DM, NIN, 32 * nb, src_col_in(32 * nb), 64 * kb}; }
DI TItem titem_late(const Params& p, int r) {
    unsigned char* ws = p.ws;
    if (r < I_CONV) { const int nb = r % (DM / 32), kb = r / (DM / 32); return TItem{p.w_conv_out, (bf16*)(ws + WS_WCONV), nullptr, DM, DM, 32 * nb, 32 * nb, 64 * kb}; } r -= I_CONV;
    if (r < I_ATT) { const int nb = r % (DM / 32), kb = r / (DM / 32); return TItem{p.w_attn_out, (bf16*)(ws + WS_WATT), nullptr, QW, DM, 32 * nb, 32 * nb, 64 * kb}; } r -= I_ATT;
    if (r < I_MIX) { const int nb = r % (DM / 32), kb = r / (DM / 32); return TItem{p.w_mix_out, (bf16*)(ws + WS_WMIX), nullptr, DM, DM, 32 * nb, 32 * nb, 64 * kb}; } r -= I_MIX;
    if (r < I_UP) { const int nb = r % (NUP / 32), kb = r / (NUP / 32); return TItem{p.w_ffn_up, (bf16*)(ws + WS_WUP), p.norm_ffn_w, DM, NUP, 32 * nb, src_col_up(32 * nb), 64 * kb}; } r -= I_UP;
    { const int nb = r % (DM / 32), kb = r / (DM / 32); return TItem{p.w_ffn_down, (bf16*)(ws + WS_WDOWN), nullptr, DFF, DM, 32 * nb, 32 * nb, 64 * kb}; }
}
template <bool LATE> DI void transpose_items(const Params& p, LAS float* scr, int w0, int nw, int nitems, int lane) {
    int it = w0; if (it >= nitems) return;
    TItem cur = LATE ? titem_late(p, it) : titem_in(p, it); f32x4 v[8]; titem_load(cur, v, lane);
    for (;;) {
        const int nx = it + nw; const bool more = nx < nitems;
        TItem nt = cur; f32x4 v2[8];
        if (more) { nt = LATE ? titem_late(p, nx) : titem_in(p, nx); titem_load(nt, v2, lane); }
        titem_finish(cur, v, scr, lane);
        if (!more) break;
#pragma unroll
        for (int i = 0; i < 8; ++i) v[i] = v2[i];
        cur = nt; it = nx;
    }
}

DI void prologue(const Params& p, LAS unsigned char* lds, int wave, int lane) {
    unsigned char* ws = p.ws;
    LAS float* scr = (LAS float*)(lds + wave * 16384);
    const int gw = blockIdx.x * NWAVES + wave, NGW = gridDim.x * NWAVES;
    const int gt = gw * 64 + lane, NGT = NGW * 64;
    transpose_items<false>(p, scr, gw, NGW, I_IN, lane);
    { float* b1 = (float*)(ws + WS_BIAS1); for (int n = gt; n < NIN; n += NGT) b1[n] = p.b_in[src_col_in(n)];
      float* s1 = (float*)(ws + WS_SS1); float* s2 = (float*)(ws + WS_SS2); for (int n = gt; n < M; n += NGT) { s1[n] = 0.f; s2[n] = 0.f; } }
    { float* RC = (float*)(ws + WS_RC); float* RS = (float*)(ws + WS_RS);
      for (int e = gt; e < M * 32; e += NGT) { const int i = e & 31, row = e >> 5;
          const float inv = exp2f(-(float)i * (13.287712379549449f / 32.0f));
          const float ang = (float)p.pos[row] * inv;
          const double xd = (double)ang; const double kq = __builtin_rint(xd * 0.63661977236758134308);
          const double rr = __builtin_fma(-kq, 6.123233995736766e-17, __builtin_fma(-kq, 1.5707963267948966, xd));
          const double r2 = rr * rr;
          const double sn = rr * (1.0 + r2 * (-1.0 / 6 + r2 * (1.0 / 120 + r2 * (-1.0 / 5040 + r2 * (1.0 / 362880 + r2 * (-1.0 / 39916800 + r2 * (1.0 / 6227020800.0)))))));
          const double cs = 1.0 + r2 * (-0.5 + r2 * (1.0 / 24 + r2 * (-1.0 / 720 + r2 * (1.0 / 40320 + r2 * (-1.0 / 3628800 + r2 * (1.0 / 479001600.0))))));
          const int q = ((int)kq) & 3;
          const double c = (q == 0) ? cs : (q == 1) ? -sn : (q == 2) ? -cs : sn;
          const double s = (q == 0) ? sn : (q == 1) ? cs : (q == 2) ? -sn : -cs;
          RC[e] = (float)c; RS[e] = (float)s; } }
    { bf16* U = (bf16*)(ws + WS_U);
      f32x4 wv[4];
#pragma unroll
      for (int j = 0; j < 4; ++j) wv[j] = *((const f32x4*)p.norm_mix_w + lane + 64 * j);
      for (int m = 2 * gw; m < M; m += 2 * NGW) {
          const f32x4* xr = (const f32x4*)(p.x + (size_t)m * DM) + lane;
          f32x4 v[2][4]; float sq[2] = {0.f, 0.f};
#pragma unroll
          for (int rr = 0; rr < 2; ++rr)
#pragma unroll
              for (int j = 0; j < 4; ++j) v[rr][j] = xr[rr * (DM / 4) + 64 * j];
#pragma unroll
          for (int rr = 0; rr < 2; ++rr)
#pragma unroll
              for (int j = 0; j < 4; ++j) sq[rr] += (v[rr][j].x * v[rr][j].x + v[rr][j].y * v[rr][j].y) + (v[rr][j].z * v[rr][j].z + v[rr][j].w * v[rr][j].w);
#pragma unroll
          for (int rr = 0; rr < 2; ++rr) { const float rstd = __builtin_amdgcn_rsqf(wave_sum(sq[rr]) * (1.0f / DM) + EPS);
              u32x2* o8 = (u32x2*)(U + (size_t)(m + rr) * DM) + lane;
#pragma unroll
              for (int j = 0; j < 4; ++j) { const f32x4 o = v[rr][j] * rstd * wv[j]; u32x2 w; w.x = pk(o[0], o[1]); w.y = pk(o[2], o[3]); o8[64 * j] = w; } }
      } }
}

#define MFMA32(a, b, c) __builtin_amdgcn_mfma_f32_32x32x16_bf16((a), (b), (c), 0, 0, 0)
DI void attn_unit(const bf16* Q, const bf16* K, const bf16* VT, bf16* ATT, const float* sinks, int u, int lane) {
    const int hq = u & 7, n = (u >> 3) & 63, b = u >> 9, kvh = hq >> 2, r = lane & 31, h = lane >> 5;
    const ptrdiff_t tok0 = (ptrdiff_t)b * SEQ + n * 128;
    const float sink = sinks[hq];
    const bf16* Kb = K + (tok0 - 128 + r) * KVW + kvh * 64 + 8 * h;
    const bf16* Vb = VT + ((ptrdiff_t)((b * 2 + kvh) * 64 + r)) * SEQ + (n * 128 - 128) + 4 * h;
    f32x16 zero;
#pragma unroll
    for (int i = 0; i < 16; ++i) zero[i] = 0.f;
    for (int qi = 0; qi < 4; ++qi) {
        const bf16* qp = Q + (tok0 + 32 * qi + r) * QW + hq * 64 + 8 * h;
        bf16x8 bq[4];
#pragma unroll
        for (int st = 0; st < 4; ++st) bq[st] = *(const bf16x8*)(qp + 16 * st);
        f32x16 S[5];
#pragma unroll
        for (int kj = 0; kj < 5; ++kj) {
            const int kt = qi + kj; S[kj] = zero;
            if (n > 0 || kt >= 4) {
                const bf16* kp = Kb + (ptrdiff_t)(32 * kt) * KVW;
                bf16x8 ak[4];
#pragma unroll
                for (int st = 0; st < 4; ++st) ak[st] = *(const bf16x8*)(kp + 16 * st);
#pragma unroll
                for (int st = 0; st < 4; ++st) S[kj] = MFMA32(ak[st], bq[st], S[kj]);
            }
        }
        float mx = sink;
#pragma unroll
        for (int kj = 0; kj < 5; ++kj) { const bool tv = (n > 0 || qi + kj >= 4);
#pragma unroll
            for (int i = 0; i < 16; ++i) { const int kr = (i & 3) + 8 * (i >> 2) + 4 * h;
                const bool valid = tv && (kj == 0 ? (kr > r) : (kj == 4 ? (kr <= r) : true));
                const float sv = valid ? S[kj][i] : -INFINITY; S[kj][i] = sv; mx = fmaxf(mx, sv); } }
        mx = fmaxf(mx, __shfl_xor(mx, 32));
        float l = 0.f;
#pragma unroll
        for (int kj = 0; kj < 5; ++kj)
#pragma unroll
            for (int i = 0; i < 16; ++i) { const float pv = __builtin_amdgcn_exp2f((S[kj][i] - mx) * LOG2E); S[kj][i] = pv; l += pv; }
        l += __shfl_xor(l, 32); l += __builtin_amdgcn_exp2f((sink - mx) * LOG2E);
        const float inv = 1.0f / l;
        f32x16 O[2] = {zero, zero};
#pragma unroll
        for (int kj = 0; kj < 5; ++kj) { const int kt = qi + kj;
            if (n > 0 || kt >= 4) {
#pragma unroll
                for (int s = 0; s < 2; ++s) {
                    u32x4 pw; pw.x = pk(S[kj][8 * s], S[kj][8 * s + 1]); pw.y = pk(S[kj][8 * s + 2], S[kj][8 * s + 3]); pw.z = pk(S[kj][8 * s + 4], S[kj][8 * s + 5]); pw.w = pk(S[kj][8 * s + 6], S[kj][8 * s + 7]);
                    const bf16x8 pb = __builtin_bit_cast(bf16x8, pw);
#pragma unroll
                    for (int dt = 0; dt < 2; ++dt) { const bf16* vp = Vb + (ptrdiff_t)(32 * dt) * SEQ + 32 * kt + 16 * s;
                        const s16x4 lo = *(const s16x4*)vp, hi = *(const s16x4*)(vp + 8);
                        const bf16x8 av = __builtin_shufflevector(lo, hi, 0, 1, 2, 3, 4, 5, 6, 7);
                        O[dt] = MFMA32(av, pb, O[dt]); }
                }
            }
        }
        bf16* op = ATT + (tok0 + 32 * qi + r) * QW + hq * 64 + 4 * h;
#pragma unroll
        for (int dt = 0; dt < 2; ++dt)
#pragma unroll
            for (int g = 0; g < 4; ++g) { u32x2 w; w.x = pk(O[dt][4 * g] * inv, O[dt][4 * g + 1] * inv); w.y = pk(O[dt][4 * g + 2] * inv, O[dt][4 * g + 3] * inv); *(u32x2*)(op + 32 * dt + 8 * g) = w; }
    }
}
DI void conv_mixer(const Params& p, int gw, int NGW, int lane) {
    const bf16* CB = (const bf16*)(p.ws + WS_CB); const bf16* P = (const bf16*)(p.ws + WS_P); bf16* H = (bf16*)(p.ws + WS_U);
    const u32x4 z = {0u, 0u, 0u, 0u};
    for (int it = gw; it < (M / 8) * 2; it += NGW) {
        const int half = it & 1, row0 = (it >> 1) * 8, s0 = row0 & (SEQ - 1); const int c0 = 512 * half + lane * 8;
        f32x4 w[3][2];
#pragma unroll
        for (int t = 0; t < 3; ++t)
#pragma unroll
            for (int hh = 0; hh < 2; ++hh) w[t][hh] = *(const f32x4*)(p.conv_mix_w + t * DM + c0 + 4 * hh);
        const size_t off = (size_t)row0 * DM + c0;
        u32x4 pr[10], cb[8];
        pr[0] = s0 ? *(const u32x4*)(P + off - 2 * DM) : z; pr[1] = s0 ? *(const u32x4*)(P + off - DM) : z;
#pragma unroll
        for (int i = 0; i < 8; ++i) { pr[2 + i] = *(const u32x4*)(P + off + (size_t)i * DM); cb[i] = *(const u32x4*)(CB + off + (size_t)i * DM); }
#pragma unroll
        for (int i = 0; i < 8; ++i) {
            const f32x4 lo = unlo(cb[i]) * (w[0][0] * unlo(pr[i]) + w[1][0] * unlo(pr[i + 1]) + w[2][0] * unlo(pr[i + 2]));
            const f32x4 hi = unhi(cb[i]) * (w[0][1] * unhi(pr[i]) + w[1][1] * unhi(pr[i + 1]) + w[2][1] * unhi(pr[i + 2]));
            *(u32x4*)(H + off + (size_t)i * DM) = pk8(lo, hi); }
    }
}

__global__ void __launch_bounds__(NWAVES * 64, 2) mega_fwd(Params p) {
    extern __shared__ __attribute__((aligned(16))) unsigned char lds_raw[];
    cg::grid_group grid = cg::this_grid();
    LAS unsigned char* lds = (LAS unsigned char*)lds_raw;
    const int tid = threadIdx.x, lane = tid & 63, wave = __builtin_amdgcn_readfirstlane(tid >> 6);
    const int G = gridDim.x, gw = blockIdx.x * NWAVES + wave, NGW = G * NWAVES;
    unsigned char* ws = p.ws;
    bf16* const Ub = (bf16*)(ws + WS_U); bf16* const CBb = (bf16*)(ws + WS_CB); bf16* const Pb = (bf16*)(ws + WS_P);
    bf16* const SGC = (bf16*)(ws + WS_SGC); bf16* const SGA = (bf16*)(ws + WS_SGA);
    bf16* const Qb = (bf16*)(ws + WS_Q); bf16* const Kb = (bf16*)(ws + WS_K); bf16* const VTb = (bf16*)(ws + WS_VT); bf16* const ATT = (bf16*)(ws + WS_ATT);
    float* const SS1 = (float*)(ws + WS_SS1); float* const SS2 = (float*)(ws + WS_SS2);

    if (tid < 32) ((LAS unsigned*)(lds + LDS_MISC))[tid] = 0u;
    __syncthreads();
    (void)xcd_barrier_post((unsigned*)(ws + WS_BAR), (volatile LAS unsigned*)(lds + LDS_MISC) + 8);
#define GRID_BAR() do { XcdBarrier b_; b_.bar = (unsigned*)(p.ws + WS_BAR); b_.x = xb_xcc_id(); b_.st = (volatile LAS unsigned*)(lds + LDS_MISC) + 8; xcd_barrier(b_); } while (0)
    REP(0) { prologue(p, lds, wave, lane);
    grid.sync(); }
    REP(1) { pg8::Gemm g{Ub, (const bf16*)(ws + WS_WIN), M, NIN, DM}; pg8::StaticOrder S; S.init(M, NIN, G, (int)blockIdx.x);
      Epi1 E{(const float*)(ws + WS_BIAS1), CBb, Pb, Qb, Kb, VTb, SGC, SGA, (const float*)(ws + WS_RC), (const float*)(ws + WS_RS)};
      pg8::gemm_phase<Epi1, pg8::StaticOrder, true, true>(lds, g, S, E);
      if ((int)blockIdx.x >= G / 2) transpose_items<true>(p, (LAS float*)(lds + wave * 16384), ((int)blockIdx.x - G / 2) * NWAVES + wave, (G - G / 2) * NWAVES, I_LATE, lane);
    GRID_BAR(); }
    REP(2) { for (int u = gw; u < BATCH * 64 * 8; u += NGW) attn_unit(Qb, Kb, VTb, ATT, p.sinks, u, lane);
    conv_mixer(p, gw, NGW, lane);
    GRID_BAR(); }
    if (PROBE_DUP == 9) { GRID_BAR(); GRID_BAR(); GRID_BAR(); GRID_BAR(); }
    { pg8::Gemm g{Ub  , (const bf16*)(ws + WS_WCONV), M, DM, DM}; pg8::StaticOrder S; S.init(M, DM, G, (int)blockIdx.x);
      Epi2a E{SGC, CBb  };
      pg8::gemm_phase<Epi2a, pg8::StaticOrder, true, true>(lds, g, S, E); }
    __syncthreads();
    { pg8::Gemm g{ATT, (const bf16*)(ws + WS_WATT), M, DM, QW}; pg8::StaticOrder S; S.init(M, DM, G, (int)blockIdx.x);
      Epi2b E{SGA, CBb  , p.b_attn_out, Pb  };
      pg8::gemm_phase<Epi2b, pg8::StaticOrder, true, true>(lds, g, S, E); }
    GRID_BAR();
    { pg8::Gemm g{Pb  , (const bf16*)(ws + WS_WMIX), M, DM, DM}; pg8::StaticOrder S; S.init(M, DM, G, (int)blockIdx.x);
      EpiRes<true> E{p.x, p.out, Ub  , SS1};
      pg8::gemm_phase<EpiRes<true>, pg8::StaticOrder, true, true>(lds, g, S, E); }
    GRID_BAR();
    { pg8::Gemm g{Ub  , (const bf16*)(ws + WS_WUP), M, NUP, DM}; pg8::StaticOrder S; S.init(M, NUP, G, (int)blockIdx.x);
      Epi4 E{SS1, p.ffn_conv_w, p.ffn_conv_b, CBb  , (float*)(ws + WS_UPH), (float*)(ws + WS_GH)};
      pg8::gemm_phase<Epi4, pg8::StaticOrder, true, true>(lds, g, S, E); }
    GRID_BAR();
    { const float* UPH = (const float*)(ws + WS_UPH); const float* GH = (const float*)(ws + WS_GH); bf16* H2 = CBb;
      for (int idx = gw * 64 + lane; idx < 512 * 2 * (DFF / 4); idx += NGW * 64) {
          const int c4 = idx % (DFF / 4), rr = (idx / (DFF / 4)) & 1, chunk = idx / (2 * (DFF / 4)), ch = 4 * c4;
          const bool first = (chunk & 127) == 0; const f32x4 z = {0.f, 0.f, 0.f, 0.f};
          const f32x4 cur = *(const f32x4*)(UPH + ((size_t)chunk * 4 + 2 + rr) * DFF + ch);
          f32x4 p1, p2;
          if (rr == 0) { p1 = first ? z : *(const f32x4*)(UPH + ((size_t)(chunk - 1) * 4 + 1) * DFF + ch); p2 = first ? z : *(const f32x4*)(UPH + ((size_t)(chunk - 1) * 4 + 0) * DFF + ch); }
          else { p1 = *(const f32x4*)(UPH + ((size_t)chunk * 4 + 2) * DFF + ch); p2 = first ? z : *(const f32x4*)(UPH + ((size_t)(chunk - 1) * 4 + 1) * DFF + ch); }
          const f32x4 gate = *(const f32x4*)(GH + ((size_t)chunk * 2 + rr) * DFF + ch);
          const f32x4 a = *(const f32x4*)(p.ffn_conv_w + 2 * DFF + ch) * cur + *(const f32x4*)(p.ffn_conv_w + DFF + ch) * p1 + *(const f32x4*)(p.ffn_conv_w + ch) * p2 + *(const f32x4*)(p.ffn_conv_b + ch);
          const f32x4 hv = a * sig4(a) * gate;
          u32x2 w; w.x = pk(hv[0], hv[1]); w.y = pk(hv[2], hv[3]);
          *(u32x2*)(H2 + (size_t)(chunk * 64 + rr) * DFF + ch) = w; } }
    GRID_BAR();
    { pg8::Gemm g{CBb  , (const bf16*)(ws + WS_WDOWN), M, DM, DFF}; pg8::StaticOrder S; S.init(M, DM, G, (int)blockIdx.x);
      EpiRes<false> E{p.out, p.out, nullptr, SS2};
      pg8::gemm_phase<EpiRes<false>, pg8::StaticOrder, true, true>(lds, g, S, E); }
    GRID_BAR();
    { f32x4 wv[4];
#pragma unroll
      for (int j = 0; j < 4; ++j) wv[j] = *((const f32x4*)p.norm_final_w + lane + 64 * j);
      for (int m = 2 * gw; m < M; m += 2 * NGW) { f32x4* xr = (f32x4*)(p.out + (size_t)m * DM) + lane;
          f32x4 v[2][4];
#pragma unroll
          for (int rr = 0; rr < 2; ++rr)
#pragma unroll
              for (int j = 0; j < 4; ++j) v[rr][j] = xr[rr * (DM / 4) + 64 * j];
#pragma unroll
          for (int rr = 0; rr < 2; ++rr) { const float rstd = __builtin_amdgcn_rsqf(SS2[m + rr] * (1.0f / DM) + EPS);
#pragma unroll
              for (int j = 0; j < 4; ++j) xr[rr * (DM / 4) + 64 * j] = v[rr][j] * rstd * wv[j]; } } }
}

extern "C" void kernel_launch(void* const* d_in, const int* in_sizes, int n_in, void* d_out, int out_size, void* d_ws, size_t ws_size, hipStream_t stream) {
    static int grid = 0;
    if (grid == 0) {
        if (n_in != 17 || in_sizes[0] != M * DM || out_size != M * DM || ws_size < WS_END) { fprintf(stderr, "kernel_launch: unexpected shapes / workspace (%d inputs, ws %zu)\n", n_in, ws_size); grid = -1; return; }
        int dev = 0, cus = 0, per_cu = 0;
        if (hipGetDevice(&dev) != hipSuccess || hipDeviceGetAttribute(&cus, hipDeviceAttributeMultiprocessorCount, dev) != hipSuccess) { grid = -1; return; }
        if (hipFuncSetAttribute((const void*)mega_fwd, hipFuncAttributeMaxDynamicSharedMemorySize, LDS_BYTES) != hipSuccess) { fprintf(stderr, "kernel_launch: hipFuncSetAttribute failed\n"); grid = -1; return; }
        if (hipOccupancyMaxActiveBlocksPerMultiprocessor(&per_cu, (const void*)mega_fwd, NWAVES * 64, LDS_BYTES) != hipSuccess || per_cu < 1) { fprintf(stderr, "kernel_launch: occupancy query says %d\n", per_cu); (void)hipGetLastError(); grid = -1; return; }
        grid = cus;
    }
    if (grid < 0) return;
    Params p{};
    p.x = (const float*)d_in[0]; p.pos = (const int*)d_in[1]; p.norm_mix_w = (const float*)d_in[2]; p.w_in = (const float*)d_in[3]; p.b_in = (const float*)d_in[4];
    p.conv_mix_w = (const float*)d_in[5]; p.w_conv_out = (const float*)d_in[6]; p.w_attn_out = (const float*)d_in[7]; p.b_attn_out = (const float*)d_in[8]; p.sinks = (const float*)d_in[9];
    p.w_mix_out = (const float*)d_in[10]; p.norm_ffn_w = (const float*)d_in[11]; p.w_ffn_up = (const float*)d_in[12]; p.ffn_conv_w = (const float*)d_in[13]; p.ffn_conv_b = (const float*)d_in[14];
    p.w_ffn_down = (const float*)d_in[15]; p.norm_final_w = (const float*)d_in[16]; p.out = (float*)d_out; p.ws = (unsigned char*)d_ws;
    if (hipMemsetAsync((char*)d_ws + WS_BAR, 0, BAR_BYTES, stream) != hipSuccess) { fprintf(stderr, "kernel_launch: memset failed\n"); return; }
    void* args[] = {&p};
    hipError_t e = hipLaunchCooperativeKernel((const void*)mega_fwd, dim3(grid), dim3(NWAVES * 64), args, LDS_BYTES, stream);
    if (e != hipSuccess) fprintf(stderr, "cooperative launch failed: %s (grid %d)\n", hipGetErrorString(e), grid);
}
```
